# Optimizing an MI355X kernel written in HIP

```python
import jax, jax.numpy as jnp
from jax import lax
import numpy as np

D_MODEL = 1024
BATCH = 4
SEQ = 4096
DEPTH = 4

HEAD_DIM = 64
N_HEADS = D_MODEL // HEAD_DIM
N_HEADS_A = N_HEADS // 2
N_KV_A = N_HEADS_A // 4
N_HEADS_B = N_HEADS - N_HEADS_A
D_FF = 4 * D_MODEL
GRID_W = 64
AXIAL_THETA = 10000.0
ROPE_THETA = 500000.0
ROPE_DIM = HEAD_DIM // 4
BLOCK_Q = 128
DILATED_PATTERNS = ((128, 1), (512, 4), (2048, 16))
NORM_EPS = 1e-6
NEG_INF = -1e30

QA_W = N_HEADS_A * HEAD_DIM
KVA_W = N_KV_A * HEAD_DIM
QB_W = N_HEADS_B * HEAD_DIM
IN_W = QA_W + 2 * KVA_W + 3 * QB_W
MIX_W = QA_W + QB_W

kernel_name = "hybrid_gqa_axial_dilated_encoder"


def rmsnorm(x, g):
    xf = x.astype(jnp.float32)
    y = xf * lax.rsqrt(jnp.mean(xf * xf, axis=-1, keepdims=True) + NORM_EPS)
    return (y * g.astype(jnp.float32)).astype(x.dtype)


def rope(x, pos, theta):
    half = x.shape[-1] // 2
    freqs = theta ** (-jnp.arange(half, dtype=jnp.float32) / half)
    ang = pos.astype(jnp.float32)[:, None] * freqs[None, :]
    cos = jnp.cos(ang)[:, None, :]
    sin = jnp.sin(ang)[:, None, :]
    xf = x.astype(jnp.float32)
    x1, x2 = xf[..., :half], xf[..., half:]
    return jnp.concatenate([x1 * cos - x2 * sin, x2 * cos + x1 * sin], axis=-1).astype(x.dtype)


def axial_rope(x, row_ids, col_ids):
    h = x.shape[-1] // 2
    return jnp.concatenate([rope(x[..., :h], row_ids, AXIAL_THETA),
                            rope(x[..., h:], col_ids, AXIAL_THETA)], axis=-1)


def partial_rope(x, pos):
    return jnp.concatenate([rope(x[..., :ROPE_DIM], pos, ROPE_THETA), x[..., ROPE_DIM:]], axis=-1)


def global_gqa(q, k, v):
    B, S, HA, hd = q.shape
    HKV = k.shape[2]
    G = HA // HKV
    nb = S // BLOCK_Q
    scale = hd ** -0.5
    qb = q.reshape(B, nb, BLOCK_Q, HKV, G, hd).transpose(1, 0, 2, 3, 4, 5)

    def one(qblk):
        s = jnp.einsum('bqkgd,bskd->bkgqs', qblk, k).astype(jnp.float32) * scale
        p = jax.nn.softmax(s, axis=-1).astype(v.dtype)
        return jnp.einsum('bkgqs,bskd->bqkgd', p, v)

    o = lax.map(one, qb)
    return o.transpose(1, 0, 2, 3, 4, 5).reshape(B, S, HA * hd)


def dilated_window_attention(q, k, v):
    B, S, H, hd = q.shape
    nb = S // BLOCK_Q
    scale = hd ** -0.5
    qb = q.reshape(B, nb, BLOCK_Q, H, hd).transpose(1, 0, 2, 3, 4)
    starts = jnp.arange(nb, dtype=jnp.int32) * BLOCK_Q

    def one(args):
        qblk, start = args
        pos = start + jnp.arange(BLOCK_Q, dtype=jnp.int32)
        outs, lses = [], []
        for window, dil in DILATED_PATTERNS:
            n_side = window // (2 * dil)
            offs = jnp.arange(-n_side, n_side + 1, dtype=jnp.int32) * dil
            idx = pos[:, None] + offs[None, :]
            valid = (idx >= 0) & (idx < S)
            idxc = jnp.clip(idx, 0, S - 1)
            kg = k[:, idxc]
            vg = v[:, idxc]
            s = jnp.einsum('bqhd,bqjhd->bhqj', qblk, kg).astype(jnp.float32) * scale
            s = jnp.where(valid[None, None], s, NEG_INF)
            lse = jax.nn.logsumexp(s, axis=-1, keepdims=True)
            p = jnp.exp(s - lse).astype(v.dtype)
            outs.append(jnp.einsum('bhqj,bqjhd->bqhd', p, vg).astype(jnp.float32))
            lses.append(lse[..., 0])
        wts = jax.nn.softmax(jnp.stack(lses, axis=0), axis=0)
        o = jnp.einsum('pbhq,pbqhd->bqhd', wts, jnp.stack(outs, axis=0))
        return o.astype(v.dtype)

    o = lax.map(one, (qb, starts))
    return o.transpose(1, 0, 2, 3, 4).reshape(B, S, H * hd)


def hybrid_layer(x, n1, w_in, q_norm, k_norm, out_norm_a, out_norm_b, w_out,
                 n2, w_mlp_in, w_mlp_out, row_ids, col_ids, pos):
    B, S, _ = x.shape
    h = rmsnorm(x, n1)
    proj = h @ w_in
    cuts = np.cumsum([QA_W, KVA_W, KVA_W, QB_W, QB_W]).tolist()
    qa, ka, va, qb, kb, vb = jnp.split(proj, cuts, axis=-1)

    qa = qa.reshape(B, S, N_HEADS_A, HEAD_DIM)
    ka = ka.reshape(B, S, N_KV_A, HEAD_DIM)
    va = va.reshape(B, S, N_KV_A, HEAD_DIM)
    qa = axial_rope(rmsnorm(qa, q_norm), row_ids, col_ids)
    ka = axial_rope(rmsnorm(ka, k_norm), row_ids, col_ids)
    ya = global_gqa(qa, ka, va)

    qb = partial_rope(qb.reshape(B, S, N_HEADS_B, HEAD_DIM), pos)
    kb = partial_rope(kb.reshape(B, S, N_HEADS_B, HEAD_DIM), pos)
    vb = vb.reshape(B, S, N_HEADS_B, HEAD_DIM)
    yb = dilated_window_attention(qb, kb, vb)

    y = jnp.concatenate([rmsnorm(ya, out_norm_a), rmsnorm(yb, out_norm_b)], axis=-1)
    x = x + y @ w_out

    u = rmsnorm(x, n2) @ w_mlp_in
    u = jnp.square(jax.nn.relu(u))
    return x + u @ w_mlp_out


def setup_inputs(seed: int = 0) -> dict:
    key = jax.random.key(seed)
    ks = jax.random.split(key, 13)
    f32 = jnp.float32

    def gain(k, shape):
        return 1.0 + 0.02 * jax.random.normal(k, shape, f32)

    return {
        "x": jax.random.normal(ks[0], (BATCH, SEQ, D_MODEL), f32),
        "norm1": gain(ks[1], (DEPTH, D_MODEL)),
        "w_in": jax.random.normal(ks[2], (DEPTH, D_MODEL, IN_W), f32) * D_MODEL ** -0.5,
        "q_norm": gain(ks[3], (DEPTH, HEAD_DIM)),
        "k_norm": gain(ks[4], (DEPTH, HEAD_DIM)),
        "out_norm_a": gain(ks[5], (DEPTH, QA_W)),
        "out_norm_b": gain(ks[6], (DEPTH, QB_W)),
        "w_out": jax.random.normal(ks[7], (DEPTH, MIX_W, D_MODEL), f32) * MIX_W ** -0.5,
        "norm2": gain(ks[8], (DEPTH, D_MODEL)),
        "w_mlp_in": jax.random.normal(ks[9], (DEPTH, D_MODEL, D_FF), f32) * D_MODEL ** -0.5,
        "w_mlp_out": jax.random.normal(ks[10], (DEPTH, D_FF, D_MODEL), f32) * D_FF ** -0.5,
        "final_norm": gain(ks[11], (D_MODEL,)),
    }


def reference(x, norm1, w_in, q_norm, k_norm, out_norm_a, out_norm_b, w_out,
              norm2, w_mlp_in, w_mlp_out, final_norm):
    S = x.shape[1]
    rows = S // GRID_W
    row_ids = jnp.repeat(jnp.arange(rows, dtype=jnp.int32), GRID_W)
    col_ids = jnp.tile(jnp.arange(GRID_W, dtype=jnp.int32), rows)
    pos = jnp.arange(S, dtype=jnp.int32)
    for l in range(DEPTH):
        x = hybrid_layer(x, norm1[l], w_in[l], q_norm[l], k_norm[l],
                         out_norm_a[l], out_norm_b[l], w_out[l], norm2[l],
                         w_mlp_in[l], w_mlp_out[l], row_ids, col_ids, pos)
    return rmsnorm(x, final_norm)
```

```cpp
#include <hip/hip_runtime.h>
#include <hip/hip_cooperative_groups.h>
#include <cstdio>
#include <cstdint>
#include <cmath>
namespace cg = cooperative_groups;
namespace pg8 {
#define PG8_LAS __attribute__((address_space(3)))
typedef unsigned short bf16_t;
typedef short bf16x8 __attribute__((ext_vector_type(8)));
typedef float f32x4 __attribute__((ext_vector_type(4)));
typedef unsigned u32x4 __attribute__((ext_vector_type(4)));
constexpr int BM = 256, BK = 64, HALF = 128, HTB = HALF * BK * 2  , STAGE_BYTES = 8 * HTB, NXCD = 8, WGM = 8;

__host__ __device__ __forceinline__ int lds_byte(int r, int c) { const int st = (r >> 4) * 2 + (c >> 5), rr = r & 15, cc = c & 31, ob = rr * 64 + cc * 2; return st * 1024 + (ob ^ (((ob >> 9) & 1) << 5)); }
__host__ __device__ __forceinline__ void stage_rc(int b, int& R, int& C) { const int st = b / 1024, sb = b % 1024, swz = sb ^ (((sb >> 9) & 1) << 5); R = (st >> 1) * 16 + swz / 64; C = (st & 1) * 32 + (swz % 64) / 2; }
__host__ __device__ __forceinline__ int perm32(int rho) { const int n = rho >> 4, i = rho & 15; return 8 * (i >> 2) + 4 * n + (i & 3); }

struct Unit { int pm, pn; };
struct Gemm { const bf16_t* A; const bf16_t* Bt; int M, N, K; };

struct StaticOrder {
    int nM, nN, nwg, G, c;
    __host__ __device__ void init(int M, int N, int G_, int c_) { nM = M / BM; nN = N / BM; nwg = nM * nN; G = G_; c = c_; }
    __host__ __device__ bool next(int i, Unit& u) const {
        const long L = (long)i * G + c; if (L >= nwg) return false;
        int wgid = (int)L; { const int q = nwg / NXCD, r = nwg % NXCD, xcd = wgid % NXCD, off = wgid / NXCD; wgid = (xcd < r ? xcd * (q + 1) : r * (q + 1) + (xcd - r) * q) + off; }
        const int nig = WGM * nN, gid = wgid / nig, fm = gid * WGM, gsz = (nM - fm) < WGM ? (nM - fm) : WGM;
        u.pm = fm + ((wgid % nig) % gsz); u.pn = (wgid % nig) / gsz; return true;
    }
    __device__ __forceinline__ void a_ready(const Unit&) const {}
    __device__ __forceinline__ void done(const Unit&) const {}
};

__device__ __forceinline__ unsigned cvt_pk_bf16(float lo, float hi) { unsigned r; asm volatile("v_cvt_pk_bf16_f32 %0, %1, %2" : "=v"(r) : "v"(lo), "v"(hi)); return r; }
typedef unsigned u32x2 __attribute__((ext_vector_type(2)));
constexpr float NORM_EPS = 1e-6f;
__device__ __forceinline__ float sum16(const float* p) { const f32x4 a = *(const f32x4*)p, b = *(const f32x4*)(p + 4), c = *(const f32x4*)(p + 8), d = *(const f32x4*)(p + 12);
    return (((a[0] + a[1]) + (a[2] + a[3])) + ((b[0] + b[1]) + (b[2] + b[3]))) + (((c[0] + c[1]) + (c[2] + c[3])) + ((d[0] + d[1]) + (d[2] + d[3]))); }
__device__ __forceinline__ float sum8(const float* p) { const f32x4 a = *(const f32x4*)p, b = *(const f32x4*)(p + 4); return ((a[0] + a[1]) + (a[2] + a[3])) + ((b[0] + b[1]) + (b[2] + b[3])); }
constexpr float QSCALE = 0.125f * 1.4426950408889634f;

struct EpiInProj {
    static constexpr bool PERM = false, AFTER_DRAIN = false, MID = false;
    const float* ss;
    const float* qg; const float* kg;
    const float* cosA; const float* sinA;
    const float* cosB; const float* sinB;
    bf16_t *QA, *KA, *VA, *QB, *KB, *VB;
    __device__ __forceinline__ void operator()(const f32x4 (&acc)[2][2][4][2], const Unit& u, int wr, int wc, int fr_, int fq_) const {
        int fr = fr_, fq = fq_; asm volatile("" : "+v"(fr), "+v"(fq));
        const int hg = u.pn * 4 + wc;
        int type; bf16_t* dst; int pitch;
        if (hg < 8)       { type = 0; dst = QA + hg * 64;        pitch = 512; }
        else if (hg < 10) { type = 1; dst = KA + (hg - 8) * 64;  pitch = 128; }
        else if (hg < 12) { type = 2; dst = VA + (hg - 10) * 64; pitch = 128; }
        else if (hg < 20) { type = 3; dst = QB + (hg - 12) * 64; pitch = 512; }
        else if (hg < 28) { type = 4; dst = KB + (hg - 20) * 64; pitch = 512; }
        else              { type = 5; dst = VB + (hg - 28) * 64; pitch = 512; }
        f32x4 g4[2][2];
        if (type <= 1) { const float* g = (type == 0) ? qg : kg;
#pragma unroll
            for (int bj = 0; bj < 2; ++bj)
#pragma unroll
                for (int n = 0; n < 2; ++n) g4[bj][n] = *(const f32x4*)(g + 32 * bj + 16 * n + 4 * fq);
        }
#pragma unroll
        for (int ai = 0; ai < 2; ++ai)
#pragma unroll
            for (int m = 0; m < 4; ++m) {
                const int row = u.pm * BM + ai * HALF + wr * 64 + m * 16 + fr;
                const int t = row & 4095;
                const float rs = rsqrtf(sum16(ss + (size_t)row * 16) * (1.0f / 1024.0f) + NORM_EPS);
                f32x4 v[2][2];
#pragma unroll
                for (int bj = 0; bj < 2; ++bj)
#pragma unroll
                    for (int n = 0; n < 2; ++n) v[bj][n] = acc[ai][bj][m][n] * rs;
                if (type <= 1) {
                    float q = 0.f;
#pragma unroll
                    for (int bj = 0; bj < 2; ++bj)
#pragma unroll
                        for (int n = 0; n < 2; ++n) { const f32x4 x = v[bj][n]; q += (x[0] * x[0] + x[1] * x[1]) + (x[2] * x[2] + x[3] * x[3]); }
                    q += __shfl_xor(q, 16); q += __shfl_xor(q, 32);
                    const float rn = rsqrtf(q * (1.0f / 64.0f) + NORM_EPS);
#pragma unroll
                    for (int bj = 0; bj < 2; ++bj) {
                        const int pos = (bj == 0) ? (t >> 6) : (t & 63);
                        const f32x4 c4 = *(const f32x4*)(cosA + pos * 16 + 4 * fq), s4 = *(const f32x4*)(sinA + pos * 16 + 4 * fq);
                        const f32x4 x1 = v[bj][0] * rn * g4[bj][0], x2 = v[bj][1] * rn * g4[bj][1];
                        v[bj][0] = x1 * c4 - x2 * s4; v[bj][1] = x2 * c4 + x1 * s4;
                    }
                } else if (type == 3 || type == 4) {
                    const f32x4 own = v[0][0]; f32x4 oth;
#pragma unroll
                    for (int j = 0; j < 4; ++j) oth[j] = __shfl_xor(own[j], 32);
                    const f32x4 c4 = *(const f32x4*)(cosB + t * 8 + 4 * (fq & 1)), s4 = *(const f32x4*)(sinB + t * 8 + 4 * (fq & 1));
                    const f32x4 os = oth * s4;
                    v[0][0] = own * c4 + ((fq < 2) ? -os : os);
                }
                if (type == 0 || type == 3) {
#pragma unroll
                    for (int bj = 0; bj < 2; ++bj)
#pragma unroll
                        for (int n = 0; n < 2; ++n) v[bj][n] = v[bj][n] * QSCALE;
                }
                bf16_t* rowp = dst + (size_t)row * pitch + 4 * fq;
#pragma unroll
                for (int bj = 0; bj < 2; ++bj)
#pragma unroll
                    for (int n = 0; n < 2; ++n) { u32x2 w; w.x = cvt_pk_bf16(v[bj][n][0], v[bj][n][1]); w.y = cvt_pk_bf16(v[bj][n][2], v[bj][n][3]);
                        *(u32x2*)(rowp + 32 * bj + 16 * n) = w; }
                asm volatile("" ::: "memory");
            }
    }
};

template <bool OUTPROJ> struct EpiRes {
    static constexpr bool PERM = false, AFTER_DRAIN = false, MID = OUTPROJ;
    const float* base; float* out; bf16_t* xb; float* ssn; const float* ssa; const float* ssb;
    __device__ __forceinline__ void mid(f32x4 (&acc)[2][2][4][2], const Unit& u, int wr, int wc, int fr_, int fq_) const {
        int fr = fr_, fq = fq_; asm volatile("" : "+v"(fr), "+v"(fq));
#pragma unroll
        for (int ai = 0; ai < 2; ++ai)
#pragma unroll
            for (int m = 0; m < 4; ++m) {
                const int row = u.pm * BM + ai * HALF + wr * 64 + m * 16 + fr;
                const float ra = rsqrtf(sum8(ssa + (size_t)row * 8) * (1.0f / 512.0f) + NORM_EPS), rb = rsqrtf(sum8(ssb + (size_t)row * 8) * (1.0f / 512.0f) + NORM_EPS);
                const float f = ra * __builtin_amdgcn_rcpf(rb);
#pragma unroll
                for (int bj = 0; bj < 2; ++bj)
#pragma unroll
                    for (int n = 0; n < 2; ++n) acc[ai][bj][m][n] = acc[ai][bj][m][n] * f;
                asm volatile("" ::: "memory");
            }
    }
    __device__ __forceinline__ void operator()(const f32x4 (&acc)[2][2][4][2], const Unit& u, int wr, int wc, int fr_, int fq_) const {
        int fr = fr_, fq = fq_; asm volatile("" : "+v"(fr), "+v"(fq));
        const int col0 = u.pn * BM + wc * 32 + 4 * fq;
#pragma unroll
        for (int ai = 0; ai < 2; ++ai)
#pragma unroll
            for (int m = 0; m < 4; ++m) {
                const int row = u.pm * BM + ai * HALF + wr * 64 + m * 16 + fr;
                float sc = 1.f;
                if (OUTPROJ) sc = rsqrtf(sum8(ssb + (size_t)row * 8) * (1.0f / 512.0f) + NORM_EPS);
                const size_t off = (size_t)row * 1024 + col0;
                float part = 0.f;
#pragma unroll
                for (int bj = 0; bj < 2; ++bj)
#pragma unroll
                    for (int n = 0; n < 2; ++n) {
                        const f32x4 bs = *(const f32x4*)(base + off + bj * HALF + n * 16);
                        const f32x4 o = bs + acc[ai][bj][m][n] * sc;
                        *(f32x4*)(out + off + bj * HALF + n * 16) = o;
                        part += (o[0] * o[0] + o[1] * o[1]) + (o[2] * o[2] + o[3] * o[3]);
                        u32x2 w; w.x = cvt_pk_bf16(o[0], o[1]); w.y = cvt_pk_bf16(o[2], o[3]);
                        *(u32x2*)(xb + off + bj * HALF + n * 16) = w;
                    }
                part += __shfl_xor(part, 16); part += __shfl_xor(part, 32);
                if (fq == 0) ssn[(size_t)row * 16 + u.pn * 4 + wc] = part;
                asm volatile("" ::: "memory");
            }
    }
};

struct EpiMlpIn {
    static constexpr bool PERM = true, AFTER_DRAIN = false, MID = false;
    const float* ss; bf16_t* O;
    __device__ __forceinline__ void operator()(const f32x4 (&acc)[2][2][4][2], const Unit& u, int wr, int wc, int fr_, int fq_) const {
        int fr = fr_, fq = fq_; asm volatile("" : "+v"(fr), "+v"(fq));
        const int col0 = u.pn * BM + wc * 32 + 8 * fq;
#pragma unroll
        for (int ai = 0; ai < 2; ++ai)
#pragma unroll
            for (int m = 0; m < 4; ++m) {
                const int row = u.pm * BM + ai * HALF + wr * 64 + m * 16 + fr;
                const float rs = rsqrtf(sum16(ss + (size_t)row * 16) * (1.0f / 1024.0f) + NORM_EPS);
                bf16_t* rowp = O + (size_t)row * 4096 + col0;
#pragma unroll
                for (int bj = 0; bj < 2; ++bj) {
                    f32x4 v0 = acc[ai][bj][m][0] * rs, v1 = acc[ai][bj][m][1] * rs;
#pragma unroll
                    for (int j = 0; j < 4; ++j) { const float a = fmaxf(v0[j], 0.f), b = fmaxf(v1[j], 0.f); v0[j] = a * a; v1[j] = b * b; }
                    u32x4 w; w.x = cvt_pk_bf16(v0[0], v0[1]); w.y = cvt_pk_bf16(v0[2], v0[3]); w.z = cvt_pk_bf16(v1[0], v1[1]); w.w = cvt_pk_bf16(v1[2], v1[3]);
                    *(u32x4*)(rowp + bj * HALF) = w;
                }
                asm volatile("" ::: "memory");
            }
    }
};
template <class Epi, class Sched, bool ALIGN_EPI = false, bool SP2 = false>
__device__ __forceinline__ void gemm_phase(PG8_LAS unsigned char* lds, const Gemm g, const Sched& S, const Epi& E) {
    const int tid = threadIdx.x, wid = __builtin_amdgcn_readfirstlane(tid >> 6), lane = tid & 63, wr = wid >> 2, wc = wid & 3, fr = lane & 15, fq = lane >> 4;
    const int K = g.K, nt = K / BK;
    unsigned voffA[2], voffB[2];
#pragma unroll
    for (int i = 0; i < 2; ++i) { int R, C; stage_rc(tid * 16 + i * 8192, R, C); const int Rb = Epi::PERM ? ((R & ~31) + perm32(R & 31)) : R;
        voffA[i] = (unsigned)(R * K + C) * 2u; voffB[i] = (unsigned)(Rb * K + C) * 2u; }
    const size_t kstep = (size_t)(BK * 2);
    const size_t hstep = (size_t)HALF * K * 2;
    const size_t tstep = 2 * hstep;
    const unsigned ldsw = (unsigned)wid * 1024u;
    const int aoff = lds_byte(wr * 64 + fr, fq * 8), boff = lds_byte(wc * 32 + fr, fq * 8);
#define PG8_SA(b, h) (((b) * 2 + (h)) * HTB)
#define PG8_SB(b, h) ((4 + (b) * 2 + (h)) * HTB)
#define PG8_STAGE(bufoff, gbase, voff) do { _Pragma("unroll") for (int _i = 0; _i < 2; ++_i) { unsigned _vo = (voff)[_i]; asm volatile("" : "+v"(_vo)); \
        __builtin_amdgcn_global_load_lds((const unsigned*)((const char*)(gbase) + _vo), (PG8_LAS unsigned*)(lds + (bufoff) + ldsw + _i * 8192), 16, 0, 0); } } while (0)
#define PG8_LDA(dst, b, h) do { _Pragma("unroll") for (int m = 0; m < 4; ++m) _Pragma("unroll") for (int k = 0; k < 2; ++k) dst[m][k] = *(const PG8_LAS bf16x8*)(lds + PG8_SA(b, h) + aoff + m * 2048 + k * 1024); } while (0)
#define PG8_LDB(dst, b, h) do { _Pragma("unroll") for (int n = 0; n < 2; ++n) _Pragma("unroll") for (int k = 0; k < 2; ++k) dst[n][k] = *(const PG8_LAS bf16x8*)(lds + PG8_SB(b, h) + boff + n * 2048 + k * 1024); } while (0)
#define PG8_MMA(ai, bj, At, Bt) do { __builtin_amdgcn_s_setprio(1); _Pragma("unroll") for (int m = 0; m < 4; ++m) _Pragma("unroll") for (int n = 0; n < 2; ++n) _Pragma("unroll") for (int k = 0; k < 2; ++k) \
        acc[ai][bj][m][n] = __builtin_amdgcn_mfma_f32_16x16x32_bf16(Bt[n][k], At[m][k], acc[ai][bj][m][n], 0, 0, 0); __builtin_amdgcn_s_setprio(0); } while (0)
#define PG8_WAIT_V(n) asm volatile("s_waitcnt vmcnt(" #n ")" ::: "memory")
#define PG8_WAIT_L(n) asm volatile("s_waitcnt lgkmcnt(" #n ")" ::: "memory")
#define PG8_BAR __builtin_amdgcn_s_barrier()
#define PG8_SCHED __builtin_amdgcn_sched_barrier(0)
    Unit cur, nxt; int ui = 0;
    if (!S.next(0, cur)) return;
    f32x4 acc[2][2][4][2];
#pragma unroll
    for (int a = 0; a < 2; ++a)
#pragma unroll
        for (int b = 0; b < 2; ++b)
#pragma unroll
            for (int m = 0; m < 4; ++m)
#pragma unroll
                for (int n = 0; n < 2; ++n) acc[a][b][m][n] = (f32x4){0.f, 0.f, 0.f, 0.f};
    bf16x8 At[4][2], B0[2][2], B1[2][2];
    const char* cA = (const char*)g.A + (size_t)cur.pm * tstep; const char* cB = (const char*)g.Bt + (size_t)cur.pn * tstep;
    S.a_ready(cur);
    if constexpr (SP2) {
        PG8_STAGE(PG8_SB(0, 0), cB, voffB); PG8_STAGE(PG8_SB(0, 1), cB + hstep, voffB); PG8_STAGE(PG8_SA(0, 0), cA, voffA); PG8_STAGE(PG8_SA(0, 1), cA + hstep, voffA);
        if (wr == 1) PG8_BAR;
        PG8_WAIT_V(2); PG8_BAR;
        PG8_STAGE(PG8_SB(1, 0), cB + kstep, voffB); PG8_STAGE(PG8_SA(1, 0), cA + kstep, voffA); PG8_STAGE(PG8_SB(1, 1), cB + hstep + kstep, voffB);
        PG8_WAIT_V(6); PG8_BAR;
    } else {
        PG8_STAGE(PG8_SB(0, 0), cB, voffB); PG8_STAGE(PG8_SA(0, 0), cA, voffA); PG8_STAGE(PG8_SB(0, 1), cB + hstep, voffB); PG8_STAGE(PG8_SA(0, 1), cA + hstep, voffA);
        if (wr == 1) PG8_BAR;
        PG8_WAIT_V(4); PG8_BAR;
        PG8_STAGE(PG8_SB(1, 0), cB + kstep, voffB); PG8_STAGE(PG8_SA(1, 0), cA + kstep, voffA); PG8_STAGE(PG8_SB(1, 1), cB + hstep + kstep, voffB);
        PG8_WAIT_V(6); PG8_BAR;
    }
    for (;;) {
        const bool has_next = S.next(ui + 1, nxt);
        const char* nA = has_next ? (const char*)g.A + (size_t)nxt.pm * tstep : cA; const char* nB = has_next ? (const char*)g.Bt + (size_t)nxt.pn * tstep : cB;
        for (int t = 0; t < nt; t += 2) {
            if constexpr (Epi::MID) { if (t == (nt >> 1)) E.mid(acc, cur, wr, wc, fr, fq); }
            const bool last = (t == nt - 2);
            const char* a1 = cA + (size_t)(t + 1) * kstep;
            const char* a2 = last ? nA : cA + (size_t)(t + 2) * kstep; const char* b2 = last ? nB : cB + (size_t)(t + 2) * kstep;
            const char* a3 = a2 + kstep; const char* b3 = b2 + kstep;
            if (last && has_next) S.a_ready(nxt);
            if constexpr (SP2) {
            PG8_LDB(B0, 0, 0); PG8_LDB(B1, 0, 1); PG8_SCHED; PG8_LDA(At, 0, 0); PG8_STAGE(PG8_SA(1, 1), a1 + hstep, voffA);
            PG8_WAIT_V(8); PG8_WAIT_L(0); PG8_BAR; PG8_MMA(0, 0, At, B0); PG8_MMA(0, 1, At, B1); PG8_BAR; PG8_SCHED;
            PG8_LDA(At, 0, 1); PG8_STAGE(PG8_SB(0, 0), b2, voffB); PG8_STAGE(PG8_SB(0, 1), b2 + hstep, voffB); PG8_STAGE(PG8_SA(0, 0), a2, voffA);
            PG8_WAIT_V(8); PG8_WAIT_L(0); PG8_BAR; PG8_MMA(1, 0, At, B0); PG8_MMA(1, 1, At, B1); PG8_BAR; PG8_SCHED;
            PG8_LDB(B0, 1, 0); PG8_LDB(B1, 1, 1); PG8_SCHED; PG8_LDA(At, 1, 0); PG8_STAGE(PG8_SA(0, 1), a2 + hstep, voffA);
            PG8_WAIT_V(8); PG8_WAIT_L(0); PG8_BAR; PG8_MMA(0, 0, At, B0); PG8_MMA(0, 1, At, B1); PG8_BAR; PG8_SCHED;
            PG8_LDA(At, 1, 1); PG8_STAGE(PG8_SB(1, 0), b3, voffB); PG8_STAGE(PG8_SB(1, 1), b3 + hstep, voffB); PG8_STAGE(PG8_SA(1, 0), a3, voffA);
            PG8_WAIT_V(8); PG8_WAIT_L(0); PG8_BAR; PG8_MMA(1, 0, At, B0); PG8_MMA(1, 1, At, B1); PG8_BAR; PG8_SCHED;
            } else {
            PG8_LDB(B0, 0, 0); PG8_SCHED; PG8_LDA(At, 0, 0); PG8_STAGE(PG8_SA(1, 1), a1 + hstep, voffA);
            PG8_WAIT_L(8); PG8_BAR; PG8_WAIT_L(0); PG8_MMA(0, 0, At, B0); PG8_BAR; PG8_SCHED;
            PG8_LDB(B1, 0, 1); PG8_STAGE(PG8_SB(0, 0), b2, voffB);
            PG8_BAR; PG8_WAIT_L(0); PG8_MMA(0, 1, At, B1); PG8_BAR;
            PG8_LDA(At, 0, 1); PG8_STAGE(PG8_SA(0, 0), a2, voffA);
            PG8_BAR; PG8_WAIT_L(0); PG8_MMA(1, 0, At, B0); PG8_BAR; PG8_SCHED;
            PG8_STAGE(PG8_SB(0, 1), b2 + hstep, voffB);
            PG8_WAIT_V(6); PG8_BAR; PG8_MMA(1, 1, At, B1); PG8_BAR;
            PG8_LDB(B0, 1, 0); PG8_SCHED; PG8_LDA(At, 1, 0); PG8_STAGE(PG8_SA(0, 1), a2 + hstep, voffA);
            PG8_WAIT_L(8); PG8_BAR; PG8_WAIT_L(0); PG8_MMA(0, 0, At, B0); PG8_BAR; PG8_SCHED;
            PG8_LDB(B1, 1, 1); PG8_STAGE(PG8_SB(1, 0), b3, voffB);
            PG8_BAR; PG8_WAIT_L(0); PG8_MMA(0, 1, At, B1); PG8_BAR;
            PG8_LDA(At, 1, 1); PG8_STAGE(PG8_SA(1, 0), a3, voffA);
            PG8_BAR; PG8_WAIT_L(0); PG8_MMA(1, 0, At, B0); PG8_BAR; PG8_SCHED;
            PG8_STAGE(PG8_SB(1, 1), b3 + hstep, voffB);
            PG8_WAIT_V(6); PG8_BAR; PG8_MMA(1, 1, At, B1); PG8_BAR;
            }
        }
        if constexpr (ALIGN_EPI) { if (wr == 0) PG8_BAR; }
        if constexpr (!Epi::AFTER_DRAIN) { E(acc, cur, wr, wc, fr, fq); S.done(cur); }
        if (!has_next) break;
#pragma unroll
        for (int a = 0; a < 2; ++a)
#pragma unroll
            for (int b = 0; b < 2; ++b)
#pragma unroll
                for (int m = 0; m < 4; ++m)
#pragma unroll
                    for (int n = 0; n < 2; ++n) acc[a][b][m][n] = (f32x4){0.f, 0.f, 0.f, 0.f};
        cur = nxt; cA = nA; cB = nB; ++ui;
        if constexpr (ALIGN_EPI) { if (wr == 1) PG8_BAR; }
    }
    PG8_WAIT_V(0);
    if constexpr (!ALIGN_EPI) { if (wr == 0) PG8_BAR; }
    PG8_BAR;
    if constexpr (Epi::AFTER_DRAIN) { E.fused(acc, cur, wr, wc, fr, fq, lds, wid, lane); S.done(cur); }
#undef PG8_SA
#undef PG8_SB
#undef PG8_STAGE
#undef PG8_LDA
#undef PG8_LDB
#undef PG8_MMA
#undef PG8_WAIT_V
#undef PG8_WAIT_L
#undef PG8_BAR
#undef PG8_SCHED
}
}

constexpr int BATCH = 4, SEQ = 4096, DM = 1024, DEPTH = 4, FF = 4096, INW = 2304;
constexpr int M = BATCH * SEQ;
constexpr size_t MiB = 1u << 20;
constexpr size_t WS_COSA = 0, WS_SINA = 4096, WS_COSB = 8192, WS_SINB = 8192 + 131072;
constexpr size_t WS_SS = 1 * MiB;
constexpr size_t WS_W = 3 * MiB;
constexpr size_t W_LAYER = 4718592 + 2 * MiB + 8 * MiB + 8 * MiB;
constexpr size_t WS_XB = 93 * MiB;
constexpr size_t WS_H = 125 * MiB;
constexpr size_t WS_QA = 125 * MiB, WS_KA = 141 * MiB, WS_VA = 145 * MiB, WS_QB = 149 * MiB, WS_KB = 165 * MiB, WS_VB = 181 * MiB, WS_Y = 197 * MiB;
constexpr size_t WS_END = 253 * MiB;
static_assert(WS_W + 4 * W_LAYER <= WS_XB, "ws map");
constexpr int LDS_BYTES = 135168;

typedef unsigned short bf16_t;
typedef short bf16x8 __attribute__((ext_vector_type(8)));
typedef short s16x4 __attribute__((ext_vector_type(4)));
typedef float f32x4 __attribute__((ext_vector_type(4)));
typedef float f32x16 __attribute__((ext_vector_type(16)));
typedef unsigned u32x2 __attribute__((ext_vector_type(2)));
typedef unsigned u32x4 __attribute__((ext_vector_type(4)));
#define LAS __attribute__((address_space(3)))

struct Params {
    const float* x; const float* norm1; const float* w_in; const float* q_norm; const float* k_norm; const float* out_norm_a; const float* out_norm_b;
    const float* w_out; const float* norm2; const float* w_mlp_in; const float* w_mlp_out; const float* final_norm;
    float* out; unsigned char* ws;
    double frev[24];
};

__device__ __forceinline__ unsigned f2bf(float f) { unsigned u = __builtin_bit_cast(unsigned, f); return (u + 0x7fffu + ((u >> 16) & 1u)) >> 16; }
__device__ __forceinline__ unsigned pk2(float lo, float hi) { return f2bf(lo) | (f2bf(hi) << 16); }
__device__ __forceinline__ float wave_sum(float v) {
#pragma unroll
    for (int o = 1; o < 64; o <<= 1) v += __shfl_xor(v, o);
    return v;
}

__device__ __forceinline__ void transpose_item(const float* W, int K, int N, bf16_t* WT, int k0, int n0, int dst_row0, const float* g0, LAS float* scr, int lane) {
#pragma unroll 8
    for (int i = 0; i < 32; ++i) { const int kk = 2 * i + (lane >> 5); float v = W[(size_t)(k0 + kk) * N + n0 + (lane & 31)]; if (g0) v *= g0[kk]; scr[kk * 33 + (lane & 31)] = v; }
    asm volatile("s_waitcnt lgkmcnt(0)" ::: "memory");
    const int c = lane & 7;
#pragma unroll
    for (int j = 0; j < 4; ++j) { const int n = (lane >> 3) + 8 * j; const LAS float* s = scr + (8 * c) * 33 + n;
        u32x4 o; o.x = pk2(s[0 * 33], s[1 * 33]); o.y = pk2(s[2 * 33], s[3 * 33]); o.z = pk2(s[4 * 33], s[5 * 33]); o.w = pk2(s[6 * 33], s[7 * 33]);
        *(u32x4*)(WT + (size_t)(dst_row0 + n) * K + k0 + 8 * c) = o; }
    asm volatile("s_waitcnt lgkmcnt(0)" ::: "memory");
}

__device__ __forceinline__ s16x4 vtr(const LAS char* p) { typedef short v4i16_t __attribute__((ext_vector_type(4))); return __builtin_bit_cast(s16x4, __builtin_amdgcn_ds_read_tr16_b64_v4i16((LAS v4i16_t*)p)); }
__device__ __forceinline__ unsigned cvtpk(float lo, float hi) { typedef float f2 __attribute__((ext_vector_type(2))); typedef __bf16 b2 __attribute__((ext_vector_type(2))); f2 v = {lo, hi}; b2 b = __builtin_convertvector(v, b2); return __builtin_bit_cast(unsigned, b); }

__device__ __forceinline__ void softmax_block(f32x16& s, float& m, float& l, f32x16 (&o)[2], bool first, bf16x8 (&pf)[2]) {
    float rm = s[0];
#pragma unroll
    for (int r = 1; r < 16; ++r) rm = fmaxf(rm, s[r]);
    rm = fmaxf(rm, __shfl_xor(rm, 32));
    const bool upd = first || (rm - m > 6.0f);
    if (__any(upd)) {
        const float mn = upd ? fmaxf(rm, -64.0f) : m;
        const float alpha = __builtin_amdgcn_exp2f(m - mn);
        m = mn; l *= alpha;
#pragma unroll
        for (int r = 0; r < 16; ++r) { o[0][r] *= alpha; o[1][r] *= alpha; }
    }
    float sum = 0.f;
#pragma unroll
    for (int r = 0; r < 16; ++r) { s[r] = __builtin_amdgcn_exp2f(s[r] - m); sum += s[r]; }
    l += sum;
    u32x4 w0, w1;
    w0.x = cvtpk(s[0], s[1]); w0.y = cvtpk(s[2], s[3]); w0.z = cvtpk(s[4], s[5]); w0.w = cvtpk(s[6], s[7]);
    w1.x = cvtpk(s[8], s[9]); w1.y = cvtpk(s[10], s[11]); w1.z = cvtpk(s[12], s[13]); w1.w = cvtpk(s[14], s[15]);
    pf[0] = __builtin_bit_cast(bf16x8, w0); pf[1] = __builtin_bit_cast(bf16x8, w1);
}

__device__ __forceinline__ void attn_store(f32x16 (&o)[2], float l, bf16_t* yrow  , float* ssrow, int h) {
    const float lt = l + __shfl_xor(l, 32);
    const float inv = 1.0f / lt;
    float q = 0.f;
#pragma unroll
    for (int db = 0; db < 2; ++db)
#pragma unroll
        for (int g = 0; g < 4; ++g) {
            const float a = o[db][4 * g] * inv, b = o[db][4 * g + 1] * inv, c = o[db][4 * g + 2] * inv, d = o[db][4 * g + 3] * inv;
            q += (a * a + b * b) + (c * c + d * d);
            u32x2 w; w.x = cvtpk(a, b); w.y = cvtpk(c, d);
            *(u32x2*)(yrow + 32 * db + 8 * g + 4 * h) = w;
        }
    q += __shfl_xor(q, 32);
    if (h == 0) *ssrow = q;
}

template <int NQ>
__device__ __forceinline__ void attn_a_wave(const bf16_t* QA, const bf16_t* KA, const bf16_t* VA, bf16_t* Y, float* ssa, int b, int head, int row0, LAS char* vst, int lane) {
    const int q = lane & 31, h = lane >> 5, kvh = head >> 2;
    bf16x8 qf[NQ][4];
#pragma unroll
    for (int nq = 0; nq < NQ; ++nq)
#pragma unroll
        for (int ds = 0; ds < 4; ++ds) qf[nq][ds] = *(const bf16x8*)(QA + (size_t)(b * SEQ + row0 + 32 * nq + q) * 512 + head * 64 + 16 * ds + 8 * h);
    f32x16 o[NQ][2]; float m[NQ], l[NQ];
#pragma unroll
    for (int nq = 0; nq < NQ; ++nq) { m[nq] = 0.f; l[nq] = 0.f;
#pragma unroll
        for (int r = 0; r < 16; ++r) { o[nq][0][r] = 0.f; o[nq][1][r] = 0.f; } }
    const bf16_t* Kp = KA + (size_t)(b * SEQ + q) * 128 + kvh * 64 + 8 * h;
    const bf16_t* Vp = VA + (size_t)(b * SEQ + (lane >> 3)) * 128 + kvh * 64 + (lane & 7) * 8;
    const int vw_off = (lane >> 3) * 128 + (((lane & 7) * 16) ^ (((lane >> 4) & 1) << 6));
    const int sw = (lane >> 3) & 1;
    const int trb = (4 * h + ((lane & 15) >> 2)) * 128 + 32 * ((lane >> 4) & 1) + 8 * (lane & 3);
    const LAS char* tr0 = vst + trb + 64 * sw;
    const LAS char* tr1 = vst + trb + 64 * (1 - sw);
    bf16x8 kn[4], vn[4];
#pragma unroll
    for (int i = 0; i < 4; ++i) { kn[i] = *(const bf16x8*)(Kp + 16 * i); vn[i] = *(const bf16x8*)(Vp + (size_t)(8 * i) * 128); }
    for (int kb = 0; kb < SEQ / 32; ++kb) {
        bf16x8 kf[4];
#pragma unroll
        for (int i = 0; i < 4; ++i) { kf[i] = kn[i]; *(LAS bf16x8*)(vst + vw_off + i * 1024) = vn[i]; }
        if (kb + 1 < SEQ / 32) {
            const bf16_t* kp2 = Kp + (size_t)(kb + 1) * 32 * 128; const bf16_t* vp2 = Vp + (size_t)(kb + 1) * 32 * 128;
#pragma unroll
            for (int i = 0; i < 4; ++i) { kn[i] = *(const bf16x8*)(kp2 + 16 * i); vn[i] = *(const bf16x8*)(vp2 + (size_t)(8 * i) * 128); }
        }
        bf16x8 pf[NQ][2];
#pragma unroll
        for (int nq = 0; nq < NQ; ++nq) {
            f32x16 s;
#pragma unroll
            for (int r = 0; r < 16; ++r) s[r] = 0.f;
#pragma unroll
            for (int ds = 0; ds < 4; ++ds) s = __builtin_amdgcn_mfma_f32_32x32x16_bf16(kf[ds], qf[nq][ds], s, 0, 0, 0);
            softmax_block(s, m[nq], l[nq], o[nq], kb == 0, pf[nq]);
        }
#pragma unroll
        for (int s2 = 0; s2 < 2; ++s2)
#pragma unroll
            for (int db = 0; db < 2; ++db) {
                const LAS char* tp = (db == 0 ? tr0 : tr1) + s2 * 2048;
                const s16x4 lo = vtr(tp), hi = vtr(tp + 1024);
                const bf16x8 vf = (bf16x8){lo[0], lo[1], lo[2], lo[3], hi[0], hi[1], hi[2], hi[3]};
#pragma unroll
                for (int nq = 0; nq < NQ; ++nq) o[nq][db] = __builtin_amdgcn_mfma_f32_32x32x16_bf16(vf, pf[nq][s2], o[nq][db], 0, 0, 0);
            }
    }
#pragma unroll
    for (int nq = 0; nq < NQ; ++nq) {
        const size_t row = (size_t)(b * SEQ + row0 + 32 * nq + q);
        attn_store(o[nq], l[nq], Y + row * 1024 + head * 64, ssa + row * 8 + head, h);
    }
}

__device__ __forceinline__ void attn_b_wave(const bf16_t* QB, const bf16_t* KB, const bf16_t* VB, bf16_t* Y, float* ssb, int b, int head, int c, int r, LAS char* vst, int lane) {
    const int q = lane & 31, h = lane >> 5;
    const int qp = 512 * c + r + 16 * q;
    bf16x8 qf[4];
#pragma unroll
    for (int ds = 0; ds < 4; ++ds) qf[ds] = *(const bf16x8*)(QB + (size_t)(b * SEQ + qp) * 512 + head * 64 + 16 * ds + 8 * h);
    f32x16 o[2]; float m = 0.f, l = 0.f;
#pragma unroll
    for (int rr = 0; rr < 16; ++rr) { o[0][rr] = 0.f; o[1][rr] = 0.f; }
    const bf16_t* Kb = KB + (size_t)(b * SEQ) * 512 + head * 64 + 8 * h;
    const bf16_t* Vb = VB + (size_t)(b * SEQ) * 512 + head * 64 + (lane & 7) * 8;
    const int vw_off = (lane >> 3) * 128 + (((lane & 7) * 16) ^ (((lane >> 4) & 1) << 6));
    const int sw = (lane >> 3) & 1;
    const int trb = (4 * h + ((lane & 15) >> 2)) * 128 + 32 * ((lane >> 4) & 1) + 8 * (lane & 3);
    const LAS char* tr0 = vst + trb + 64 * sw;
    const LAS char* tr1 = vst + trb + 64 * (1 - sw);
    const int base = 512 * c + r;
#define BLK_INFO(i, dil, ks) do { if ((i) < 5) { dil = 16; ks = base - 1024 + 512 * (i); } else if ((i) < 13) { dil = 4; ks = base - 256 + 128 * ((i) - 5); } else { dil = 1; ks = base - 64 + 32 * ((i) - 13); } } while (0)
    bf16x8 kn[4], vn[4];
    { int dil, ks; BLK_INFO(0, dil, ks);
      int kp = ks + dil * q; kp = kp < 0 ? 0 : (kp > SEQ - 1 ? SEQ - 1 : kp);
#pragma unroll
      for (int i = 0; i < 4; ++i) { kn[i] = *(const bf16x8*)(Kb + (size_t)kp * 512 + 16 * i);
          int vp = ks + dil * (8 * i + (lane >> 3)); vp = vp < 0 ? 0 : (vp > SEQ - 1 ? SEQ - 1 : vp);
          vn[i] = *(const bf16x8*)(Vb + (size_t)vp * 512); } }
    for (int bi = 0; bi < 33; ++bi) {
        int dil, ks; BLK_INFO(bi, dil, ks);
        bf16x8 kf[4];
#pragma unroll
        for (int i = 0; i < 4; ++i) { kf[i] = kn[i]; *(LAS bf16x8*)(vst + vw_off + i * 1024) = vn[i]; }
        if (bi + 1 < 33) {
            int dil2, ks2; BLK_INFO(bi + 1, dil2, ks2);
            int kp = ks2 + dil2 * q; kp = kp < 0 ? 0 : (kp > SEQ - 1 ? SEQ - 1 : kp);
#pragma unroll
            for (int i = 0; i < 4; ++i) { kn[i] = *(const bf16x8*)(Kb + (size_t)kp * 512 + 16 * i);
                int vp = ks2 + dil2 * (8 * i + (lane >> 3)); vp = vp < 0 ? 0 : (vp > SEQ - 1 ? SEQ - 1 : vp);
                vn[i] = *(const bf16x8*)(Vb + (size_t)vp * 512); }
        }
        f32x16 s;
#pragma unroll
        for (int rr = 0; rr < 16; ++rr) s[rr] = 0.f;
#pragma unroll
        for (int ds = 0; ds < 4; ++ds) s = __builtin_amdgcn_mfma_f32_32x32x16_bf16(kf[ds], qf[ds], s, 0, 0, 0);
        const int lim = 64 * dil;
        const int e0 = ks + dil * 4 * h - qp;
#pragma unroll
        for (int rr = 0; rr < 16; ++rr) {
            const int diff = e0 + dil * ((rr & 3) + 8 * (rr >> 2));
            const int kp = qp + diff;
            const bool valid = (diff >= -lim) && (diff <= lim) && (kp >= 0) && (kp < SEQ);
            s[rr] = valid ? s[rr] : -1e30f;
        }
        bf16x8 pf[2];
        softmax_block(s, m, l, o, bi == 0, pf);
#pragma unroll
        for (int s2 = 0; s2 < 2; ++s2)
#pragma unroll
            for (int db = 0; db < 2; ++db) {
                const LAS char* tp = (db == 0 ? tr0 : tr1) + s2 * 2048;
                const s16x4 lo = vtr(tp), hi = vtr(tp + 1024);
                const bf16x8 vf = (bf16x8){lo[0], lo[1], lo[2], lo[3], hi[0], hi[1], hi[2], hi[3]};
                o[db] = __builtin_amdgcn_mfma_f32_32x32x16_bf16(vf, pf[s2], o[db], 0, 0, 0);
            }
    }
#undef BLK_INFO
    const size_t row = (size_t)(b * SEQ + qp);
    attn_store(o, l, Y + row * 1024 + 512 + head * 64, ssb + row * 8 + head, h);
}

#define GRID_SYNC() do { asm volatile("s_waitcnt vmcnt(0) lgkmcnt(0)" ::: "memory"); grid.sync(); __builtin_amdgcn_fence(__ATOMIC_ACQUIRE, "agent"); asm volatile("s_waitcnt vmcnt(0)" ::: "memory"); } while (0)
constexpr int ATT_NQ = 2;
__global__ void __launch_bounds__(512) fwd_megakernel(Params p) {
    extern __shared__ __attribute__((aligned(16))) unsigned char lds_raw[];
    LAS unsigned char* lds = (LAS unsigned char*)lds_raw;
    cg::grid_group grid = cg::this_grid();
    const int tid = threadIdx.x, lane = tid & 63, wave = __builtin_amdgcn_readfirstlane(tid >> 6);
    const int G = gridDim.x, bx = blockIdx.x;
    const int gw = bx * 8 + wave, NGW = G * 8;
    unsigned char* ws = p.ws;
    float* cosA = (float*)(ws + WS_COSA); float* sinA = (float*)(ws + WS_SINA); float* cosB = (float*)(ws + WS_COSB); float* sinB = (float*)(ws + WS_SINB);
    float* SSP = (float*)(ws + WS_SS); float* SSA = SSP + (size_t)M * 16; float* SSB = SSA + (size_t)M * 8;
    bf16_t* XB = (bf16_t*)(ws + WS_XB);
    bf16_t* HB = (bf16_t*)(ws + WS_H);
    bf16_t *QA = (bf16_t*)(ws + WS_QA), *KA = (bf16_t*)(ws + WS_KA), *VA = (bf16_t*)(ws + WS_VA), *QB = (bf16_t*)(ws + WS_QB), *KB = (bf16_t*)(ws + WS_KB), *VB = (bf16_t*)(ws + WS_VB), *Y = (bf16_t*)(ws + WS_Y);

    {
        LAS float* scr = (LAS float*)(lds + wave * 16384);
        constexpr int I_IN = 16 * 72, I_OUT = 16 * 32, I_1 = 16 * 128, I_2 = 64 * 32, I_L = I_IN + I_OUT + I_1 + I_2;
        for (int it = gw; it < DEPTH * I_L; it += NGW) {
            const int L = it / I_L; int r = it % I_L;
            bf16_t* wl = (bf16_t*)(ws + WS_W + (size_t)L * W_LAYER);
            if (r < I_IN) { const int kb = r / 72, nb = r % 72, n0 = 32 * nb, k0 = 64 * kb;
                const int d0 = (n0 & ~255) + ((n0 >> 5) & 1) * 128 + ((n0 >> 6) & 3) * 32;
                transpose_item(p.w_in + (size_t)L * DM * INW, DM, INW, wl, k0, n0, d0, p.norm1 + L * DM + k0, scr, lane); continue; }
            r -= I_IN;
            if (r < I_OUT) { const int kb = r / 32, nb = r % 32, n0 = 32 * nb, k0 = 64 * kb;
                const float* g0 = (k0 < 512) ? p.out_norm_a + L * 512 + k0 : p.out_norm_b + L * 512 + (k0 - 512);
                transpose_item(p.w_out + (size_t)L * DM * DM, DM, DM, wl + 2359296, k0, n0, n0, g0, scr, lane); continue; }
            r -= I_OUT;
            if (r < I_1) { const int kb = r / 128, nb = r % 128, n0 = 32 * nb, k0 = 64 * kb;
                transpose_item(p.w_mlp_in + (size_t)L * DM * FF, DM, FF, wl + 2359296 + 1048576, k0, n0, n0, p.norm2 + L * DM + k0, scr, lane); continue; }
            r -= I_1;
            { const int kb = r / 32, nb = r % 32, n0 = 32 * nb, k0 = 64 * kb;
                transpose_item(p.w_mlp_out + (size_t)L * FF * DM, FF, DM, wl + 2359296 + 1048576 + 4194304, k0, n0, n0, nullptr, scr, lane); }
        }
        for (int mrow = gw; mrow < M; mrow += NGW) {
            const f32x4* xr = (const f32x4*)(p.x + (size_t)mrow * DM) + lane; float s = 0.f;
            unsigned long long* o8 = (unsigned long long*)(XB + (size_t)mrow * DM) + lane;
#pragma unroll
            for (int j = 0; j < 4; ++j) { const f32x4 v = xr[64 * j]; s += (v[0] * v[0] + v[1] * v[1]) + (v[2] * v[2] + v[3] * v[3]);
                o8[64 * j] = (unsigned long long)pk2(v[0], v[1]) | ((unsigned long long)pk2(v[2], v[3]) << 32); }
            s = wave_sum(s);
            if (lane < 16) SSP[(size_t)mrow * 16 + lane] = (lane == 0) ? s : 0.f;
        }
        for (int i = bx * 512 + tid; i < 64 * 16 + 4096 * 8; i += G * 512) {
            int fi, pos; if (i < 1024) { fi = i & 15; pos = i >> 4; } else { fi = 16 + ((i - 1024) & 7); pos = (i - 1024) >> 3; }
            double f = 0.0;
#pragma unroll
            for (int k = 0; k < 24; ++k) if (fi == k) f = p.frev[k];
            double rev = (double)pos * f; rev -= floor(rev);
            const float fr = (float)rev;
            const float sv = __builtin_amdgcn_sinf(fr), cv = __builtin_amdgcn_cosf(fr);
            if (i < 1024) { cosA[i] = cv; sinA[i] = sv; } else { cosB[i - 1024] = cv; sinB[i - 1024] = sv; }
        }
    }
    GRID_SYNC();

    for (int L = 0; L < DEPTH; ++L) {
        const bf16_t* wl = (const bf16_t*)(ws + WS_W + (size_t)L * W_LAYER);
        const bf16_t* Win = wl; const bf16_t* Wout = wl + 2359296; const bf16_t* W1 = Wout + 1048576; const bf16_t* W2 = W1 + 4194304;
        float* ss1 = SSP; float* ss2 = SSP; float* ssn = SSP; float* ssa = SSA; float* ssb = SSB;
        {
            pg8::Gemm g{XB, Win, M, INW, DM}; pg8::StaticOrder S; S.init(M, INW, G, bx);
            pg8::EpiInProj E{ss1, p.q_norm + L * 64, p.k_norm + L * 64, cosA, sinA, cosB, sinB, QA, KA, VA, QB, KB, VB};
            pg8::gemm_phase<pg8::EpiInProj, pg8::StaticOrder, true, true>(lds, g, S, E);
        }
        GRID_SYNC();
        {
            LAS char* vst = (LAS char*)(lds + wave * 4096);
            const int vb = (bx & 7) * (G >> 3) + (bx >> 3);
            constexpr int ROWS_U = 256 * ATT_NQ, UPH = SEQ / ROWS_U;
            for (int u = vb; u < BATCH * 8 * UPH; u += G) {
                const int b = u / (8 * UPH), head = (u / UPH) & 7, cchunk = u % UPH;
                attn_a_wave<ATT_NQ>(QA, KA, VA, Y, ssa, b, head, cchunk * ROWS_U + wave * 32 * ATT_NQ, vst, lane);
            }
            for (int grp = vb; grp < BATCH * 8 * 8; grp += G) {
                const int b = grp >> 6, head = (grp >> 3) & 7, c = grp & 7;
                attn_b_wave(QB, KB, VB, Y, ssb, b, head, c, wave, vst, lane);
                attn_b_wave(QB, KB, VB, Y, ssb, b, head, c, wave + 8, vst, lane);
            }
        }
        GRID_SYNC();
        {
            pg8::Gemm g{Y, Wout, M, DM, DM}; pg8::StaticOrder S; S.init(M, DM, G, bx);
            pg8::EpiRes<true> E{L == 0 ? p.x : p.out, p.out, XB, ss2, ssa, ssb};
            pg8::gemm_phase<pg8::EpiRes<true>, pg8::StaticOrder, true, true>(lds, g, S, E);
        }
        GRID_SYNC();
        {
            pg8::Gemm g{XB, W1, M, FF, DM}; pg8::StaticOrder S; S.init(M, FF, G, bx);
            pg8::EpiMlpIn E{ss2, HB};
            pg8::gemm_phase<pg8::EpiMlpIn, pg8::StaticOrder, true, true>(lds, g, S, E);
        }
        GRID_SYNC();
        {
            pg8::Gemm g{HB, W2, M, DM, FF}; pg8::StaticOrder S; S.init(M, DM, G, bx);
            pg8::EpiRes<false> E{p.out, p.out, XB, ssn, nullptr, nullptr};
            pg8::gemm_phase<pg8::EpiRes<false>, pg8::StaticOrder, true, true>(lds, g, S, E);
        }
        GRID_SYNC();
    }
    {
        const float* ssf = SSP;
        for (int mrow = gw; mrow < M; mrow += NGW) {
            const float rs = rsqrtf(pg8::sum16(ssf + (size_t)mrow * 16) * (1.0f / 1024.0f) + 1e-6f);
            f32x4* xr = (f32x4*)(p.out + (size_t)mrow * DM) + lane; const f32x4* gr = (const f32x4*)p.final_norm + lane;
#pragma unroll
            for (int j = 0; j < 4; ++j) { const f32x4 v = xr[64 * j]; xr[64 * j] = v * rs * gr[64 * j]; }
        }
    }
}

extern "C" void kernel_launch(void* const* d_in, const int* in_sizes, int n_in, void* d_out, int out_size, void* d_ws, size_t ws_size, hipStream_t stream) {
    static int grid_blocks = 0;
    if (grid_blocks == 0) {
        if (n_in != 12 || ws_size < WS_END) { fprintf(stderr, "kernel_launch: unexpected inputs (n_in %d, ws %zu)\n", n_in, ws_size); grid_blocks = -1; return; }
        int dev = 0, cus = 0, per_cu = 0;
        hipGetDevice(&dev);
        hipDeviceGetAttribute(&cus, hipDeviceAttributeMultiprocessorCount, dev);
        hipFuncSetAttribute((const void*)fwd_megakernel, hipFuncAttributeMaxDynamicSharedMemorySize, LDS_BYTES);
        hipOccupancyMaxActiveBlocksPerMultiprocessor(&per_cu, (const void*)fwd_megakernel, 512, LDS_BYTES);
        if (per_cu < 1) { fprintf(stderr, "kernel_launch: occupancy query says %d blocks per CU\n", per_cu); grid_blocks = -1; return; }
        grid_blocks = cus * per_cu;
        if (grid_blocks % 8 != 0) grid_blocks -= grid_blocks % 8;
    }
    if (grid_blocks < 0) return;
    Params p{};
    p.x = (const float*)d_in[0]; p.norm1 = (const float*)d_in[1]; p.w_in = (const float*)d_in[2]; p.q_norm = (const float*)d_in[3]; p.k_norm = (const float*)d_in[4];
    p.out_norm_a = (const float*)d_in[5]; p.out_norm_b = (const float*)d_in[6]; p.w_out = (const float*)d_in[7]; p.norm2 = (const float*)d_in[8];
    p.w_mlp_in = (const float*)d_in[9]; p.w_mlp_out = (const float*)d_in[10]; p.final_norm = (const float*)d_in[11];
    p.out = (float*)d_out; p.ws = (unsigned char*)d_ws;
    const double two_pi = 6.283185307179586476925286766559;
    for (int i = 0; i < 16; ++i) p.frev[i] = pow(10000.0, -(double)i / 16.0) / two_pi;
    for (int i = 0; i < 8; ++i) p.frev[16 + i] = pow(500000.0, -(double)i / 8.0) / two_pi;
    void* args[] = {&p};
    hipError_t e = hipLaunchCooperativeKernel((const void*)fwd_megakernel, dim3(grid_blocks), dim3(512), args, LDS_BYTES, stream);
    if (e != hipSuccess) fprintf(stderr, "cooperative launch failed: %s (grid %d)\n", hipGetErrorString(e), grid_blocks);
}
```

```cpp
#include <hip/hip_runtime.h>
#include <hip/hip_cooperative_groups.h>
#include <cstdio>
#include <cstdint>
#include <cmath>
namespace cg = cooperative_groups;
namespace pg8 {
#define PG8_LAS __attribute__((address_space(3)))
typedef unsigned short bf16_t;
typedef short bf16x8 __attribute__((ext_vector_type(8)));
typedef float f32x4 __attribute__((ext_vector_type(4)));
typedef unsigned u32x4 __attribute__((ext_vector_type(4)));
constexpr int BM = 256, BK = 64, HALF = 128, HTB = HALF * BK * 2  , STAGE_BYTES = 8 * HTB, NXCD = 8, WGM = 8;

__host__ __device__ __forceinline__ int lds_byte(int r, int c) { const int st = (r >> 4) * 2 + (c >> 5), rr = r & 15, cc = c & 31, ob = rr * 64 + cc * 2; return st * 1024 + (ob ^ (((ob >> 9) & 1) << 5)); }
__host__ __device__ __forceinline__ void stage_rc(int b, int& R, int& C) { const int st = b / 1024, sb = b % 1024, swz = sb ^ (((sb >> 9) & 1) << 5); R = (st >> 1) * 16 + swz / 64; C = (st & 1) * 32 + (swz % 64) / 2; }
__host__ __device__ __forceinline__ int perm32(int rho) { const int n = rho >> 4, i = rho & 15; return 8 * (i >> 2) + 4 * n + (i & 3); }

struct Unit { int pm, pn; };
struct Gemm { const bf16_t* A; const bf16_t* Bt; int M, N, K; };

struct StaticOrder {
    int nM, nN, nwg, G, c;
    __host__ __device__ void init(int M, int N, int G_, int c_) { nM = M / BM; nN = N / BM; nwg = nM * nN; G = G_; c = c_; }
    __host__ __device__ bool next(int i, Unit& u) const {
        const long L = (long)i * G + c; if (L >= nwg) return false;
        int wgid = (int)L; { const int q = nwg / NXCD, r = nwg % NXCD, xcd = wgid % NXCD, off = wgid / NXCD; wgid = (xcd < r ? xcd * (q + 1) : r * (q + 1) + (xcd - r) * q) + off; }
        const int nig = WGM * nN, gid = wgid / nig, fm = gid * WGM, gsz = (nM - fm) < WGM ? (nM - fm) : WGM;
        u.pm = fm + ((wgid % nig) % gsz); u.pn = (wgid % nig) / gsz; return true;
    }
    __device__ __forceinline__ void a_ready(const Unit&) const {}
    __device__ __forceinline__ void done(const Unit&) const {}
};

__device__ __forceinline__ unsigned cvt_pk_bf16(float lo, float hi) { unsigned r; asm volatile("v_cvt_pk_bf16_f32 %0, %1, %2" : "=v"(r) : "v"(lo), "v"(hi)); return r; }
typedef unsigned u32x2 __attribute__((ext_vector_type(2)));
constexpr float NORM_EPS = 1e-6f;
__device__ __forceinline__ float sum16(const float* p) { const f32x4 a = *(const f32x4*)p, b = *(const f32x4*)(p + 4), c = *(const f32x4*)(p + 8), d = *(const f32x4*)(p + 12);
    return (((a[0] + a[1]) + (a[2] + a[3])) + ((b[0] + b[1]) + (b[2] + b[3]))) + (((c[0] + c[1]) + (c[2] + c[3])) + ((d[0] + d[1]) + (d[2] + d[3]))); }
__device__ __forceinline__ float sum8(const float* p) { const f32x4 a = *(const f32x4*)p, b = *(const f32x4*)(p + 4); return ((a[0] + a[1]) + (a[2] + a[3])) + ((b[0] + b[1]) + (b[2] + b[3])); }
template <int NP> __device__ __forceinline__ void rows_rstd(const float* ss, int row0, int fq, float inv_n, float (&rs)[8]) {
    f32x4 v[8];
#pragma unroll
    for (int i = 0; i < 8; ++i) v[i] = *(const f32x4*)(ss + (size_t)(row0 + (i >> 2) * HALF + (i & 3) * 16) * NP + 4 * (fq & (NP / 4 - 1)));
#pragma unroll
    for (int i = 0; i < 8; ++i) { float q = (v[i][0] + v[i][1]) + (v[i][2] + v[i][3]); q += __shfl_xor(q, 16); if (NP == 16) q += __shfl_xor(q, 32); rs[i] = rsqrtf(q * inv_n + NORM_EPS); }
}
constexpr float QSCALE = 0.125f * 1.4426950408889634f;

struct EpiInProj {
    static constexpr bool PERM = false, AFTER_DRAIN = false, MID = false;
    const float* ss;
    const float* qg; const float* kg;
    const float* cosA; const float* sinA;
    const float* cosB; const float* sinB;
    bf16_t *QA, *KA, *VA, *QB, *KB, *VB;
    __device__ __forceinline__ void operator()(const f32x4 (&acc)[2][2][4][2], const Unit& u, int wr, int wc, int fr_, int fq_) const {
        int fr = fr_, fq = fq_; asm volatile("" : "+v"(fr), "+v"(fq));
        const int otile = (u.pn == 0) ? 7 : ((u.pn == 4) ? 8 : ((u.pn < 4) ? u.pn - 1 : u.pn - 2));
        const int hg = otile * 4 + wc;
        int type; bf16_t* dst; int pitch;
        if (hg < 8)       { type = 0; dst = QA + hg * 64;        pitch = 512; }
        else if (hg < 10) { type = 1; dst = KA + (hg - 8) * 64;  pitch = 128; }
        else if (hg < 12) { type = 2; dst = VA + (hg - 10) * 64; pitch = 128; }
        else if (hg < 20) { type = 3; dst = QB + (hg - 12) * 64; pitch = 512; }
        else if (hg < 28) { type = 4; dst = KB + (hg - 20) * 64; pitch = 512; }
        else              { type = 5; dst = VB + (hg - 28) * 64; pitch = 512; }
        const float* __restrict__ cosA_ = cosA; const float* __restrict__ sinA_ = sinA; const float* __restrict__ cosB_ = cosB; const float* __restrict__ sinB_ = sinB;
        bf16_t* __restrict__ dst_ = dst;
        f32x4 g4[2][2];
        if (type <= 1) { const float* g = (type == 0) ? qg : kg;
#pragma unroll
            for (int bj = 0; bj < 2; ++bj)
#pragma unroll
                for (int n = 0; n < 2; ++n) g4[bj][n] = *(const f32x4*)(g + 32 * bj + 16 * n + 4 * fq);
        }
        float rs8[8]; rows_rstd<16>(ss, u.pm * BM + wr * 64 + fr, fq, 1.0f / 1024.0f, rs8);
#pragma unroll
        for (int ai = 0; ai < 2; ++ai)
#pragma unroll
            for (int m = 0; m < 4; ++m) {
                const int row = u.pm * BM + ai * HALF + wr * 64 + m * 16 + fr;
                const int t = row & 4095;
                const float rs = rs8[ai * 4 + m];
                f32x4 v[2][2];
#pragma unroll
                for (int bj = 0; bj < 2; ++bj)
#pragma unroll
                    for (int n = 0; n < 2; ++n) v[bj][n] = acc[ai][bj][m][n] * rs;
                if (type <= 1) {
                    float q = 0.f;
#pragma unroll
                    for (int bj = 0; bj < 2; ++bj)
#pragma unroll
                        for (int n = 0; n < 2; ++n) { const f32x4 x = v[bj][n]; q += (x[0] * x[0] + x[1] * x[1]) + (x[2] * x[2] + x[3] * x[3]); }
                    q += __shfl_xor(q, 16); q += __shfl_xor(q, 32);
                    const float rn = rsqrtf(q * (1.0f / 64.0f) + NORM_EPS);
#pragma unroll
                    for (int bj = 0; bj < 2; ++bj) {
                        const int pos = (bj == 0) ? (t >> 6) : (t & 63);
                        const f32x4 c4 = *(const f32x4*)(cosA_ + pos * 16 + 4 * fq), s4 = *(const f32x4*)(sinA_ + pos * 16 + 4 * fq);
                        const f32x4 x1 = v[bj][0] * rn * g4[bj][0], x2 = v[bj][1] * rn * g4[bj][1];
                        v[bj][0] = x1 * c4 - x2 * s4; v[bj][1] = x2 * c4 + x1 * s4;
                    }
                } else if (type == 3 || type == 4) {
                    const f32x4 own = v[0][0]; f32x4 oth;
#pragma unroll
                    for (int j = 0; j < 4; ++j) oth[j] = __shfl_xor(own[j], 32);
                    const f32x4 c4 = *(const f32x4*)(cosB_ + t * 8 + 4 * (fq & 1)), s4 = *(const f32x4*)(sinB_ + t * 8 + 4 * (fq & 1));
                    const f32x4 os = oth * s4;
                    v[0][0] = own * c4 + ((fq < 2) ? -os : os);
                }
                if (type == 0 || type == 3) {
#pragma unroll
                    for (int bj = 0; bj < 2; ++bj)
#pragma unroll
                        for (int n = 0; n < 2; ++n) v[bj][n] = v[bj][n] * QSCALE;
                }
                bf16_t* rowp = dst_ + (size_t)row * pitch + 4 * fq;
#pragma unroll
                for (int bj = 0; bj < 2; ++bj)
#pragma unroll
                    for (int n = 0; n < 2; ++n) { u32x2 w; w.x = cvt_pk_bf16(v[bj][n][0], v[bj][n][1]); w.y = cvt_pk_bf16(v[bj][n][2], v[bj][n][3]);
                        *(u32x2*)(rowp + 32 * bj + 16 * n) = w; }
                asm volatile("" ::: "memory");
            }
    }
};

template <bool OUTPROJ> struct EpiRes {
    static constexpr bool PERM = false, AFTER_DRAIN = false, MID = OUTPROJ;
    bf16_t* xb; float* ssn; const float* ssa; const float* ssb;
    __device__ __forceinline__ void mid(f32x4 (&acc)[2][2][4][2], const Unit& u, int wr, int wc, int fr_, int fq_) const {
        int fr = fr_, fq = fq_; asm volatile("" : "+v"(fr), "+v"(fq));
        float ra[8], rb[8]; rows_rstd<8>(ssa, u.pm * BM + wr * 64 + fr, fq, 1.0f / 512.0f, ra); rows_rstd<8>(ssb, u.pm * BM + wr * 64 + fr, fq, 1.0f / 512.0f, rb);
#pragma unroll
        for (int ai = 0; ai < 2; ++ai)
#pragma unroll
            for (int m = 0; m < 4; ++m) {
                const float f = ra[ai * 4 + m] * __builtin_amdgcn_rcpf(rb[ai * 4 + m]);
#pragma unroll
                for (int bj = 0; bj < 2; ++bj)
#pragma unroll
                    for (int n = 0; n < 2; ++n) acc[ai][bj][m][n] = acc[ai][bj][m][n] * f;
            }
    }
    __device__ __forceinline__ void operator()(const f32x4 (&acc)[2][2][4][2], const Unit& u, int wr, int wc, int fr_, int fq_) const {
        int fr = fr_, fq = fq_; asm volatile("" : "+v"(fr), "+v"(fq));
        const int col0 = u.pn * BM + wc * 32 + 4 * fq, row0 = u.pm * BM + wr * 64 + fr;
        float sc8[8];
        if (OUTPROJ) rows_rstd<8>(ssb, row0, fq, 1.0f / 512.0f, sc8);
#pragma unroll
        for (int ai = 0; ai < 2; ++ai) {
            u32x2 wb[4][2][2];
#pragma unroll
            for (int m = 0; m < 4; ++m)
#pragma unroll
                for (int bj = 0; bj < 2; ++bj)
#pragma unroll
                    for (int n = 0; n < 2; ++n) wb[m][bj][n] = *(const u32x2*)(xb + (size_t)(row0 + ai * HALF + m * 16) * 1024 + col0 + bj * HALF + n * 16);
#pragma unroll
            for (int m = 0; m < 4; ++m) {
                const int row = row0 + ai * HALF + m * 16;
                const float sc = OUTPROJ ? sc8[ai * 4 + m] : 1.f;
                const size_t off = (size_t)row * 1024 + col0;
                float part = 0.f;
#pragma unroll
                for (int bj = 0; bj < 2; ++bj)
#pragma unroll
                    for (int n = 0; n < 2; ++n) {
                        const u32x2 w_ = wb[m][bj][n];
                        const f32x4 bs = (f32x4){__uint_as_float(w_.x << 16), __uint_as_float(w_.x & 0xffff0000u), __uint_as_float(w_.y << 16), __uint_as_float(w_.y & 0xffff0000u)};
                        const f32x4 o = bs + acc[ai][bj][m][n] * sc;
                        part += (o[0] * o[0] + o[1] * o[1]) + (o[2] * o[2] + o[3] * o[3]);
                        u32x2 w; w.x = cvt_pk_bf16(o[0], o[1]); w.y = cvt_pk_bf16(o[2], o[3]);
                        *(u32x2*)(xb + off + bj * HALF + n * 16) = w;
                    }
                part += __shfl_xor(part, 16); part += __shfl_xor(part, 32);
                if (fq == 0) ssn[(size_t)row * 16 + u.pn * 4 + wc] = part;
            }
        }
    }
};

struct EpiMlpIn {
    static constexpr bool PERM = true, AFTER_DRAIN = false, MID = false;
    const float* ss; bf16_t* O;
    __device__ __forceinline__ void operator()(const f32x4 (&acc)[2][2][4][2], const Unit& u, int wr, int wc, int fr_, int fq_) const {
        int fr = fr_, fq = fq_; asm volatile("" : "+v"(fr), "+v"(fq));
        const int col0 = u.pn * BM + wc * 32 + 8 * fq;
        float rs8[8]; rows_rstd<16>(ss, u.pm * BM + wr * 64 + fr, fq, 1.0f / 1024.0f, rs8);
#pragma unroll
        for (int ai = 0; ai < 2; ++ai)
#pragma unroll
            for (int m = 0; m < 4; ++m) {
                const int row = u.pm * BM + ai * HALF + wr * 64 + m * 16 + fr;
                const float rs = rs8[ai * 4 + m];
                bf16_t* rowp = O + (size_t)row * 4096 + col0;
#pragma unroll
                for (int bj = 0; bj < 2; ++bj) {
                    f32x4 v0 = acc[ai][bj][m][0] * rs, v1 = acc[ai][bj][m][1] * rs;
#pragma unroll
                    for (int j = 0; j < 4; ++j) { const float a = fmaxf(v0[j], 0.f), b = fmaxf(v1[j], 0.f); v0[j] = a * a; v1[j] = b * b; }
                    u32x4 w; w.x = cvt_pk_bf16(v0[0], v0[1]); w.y = cvt_pk_bf16(v0[2], v0[3]); w.z = cvt_pk_bf16(v1[0], v1[1]); w.w = cvt_pk_bf16(v1[2], v1[3]);
                    *(u32x4*)(rowp + bj * HALF) = w;
                }
                asm volatile("" ::: "memory");
            }
    }
};
template <class Epi, class Sched, bool ALIGN_EPI = false, bool SP2 = false>
__device__ __forceinline__ void gemm_phase(PG8_LAS unsigned char* lds, const Gemm g, const Sched& S, const Epi& E) {
    int tid_ = threadIdx.x; asm volatile("" : "+v"(tid_));
    const int tid = tid_, wid = __builtin_amdgcn_readfirstlane(tid >> 6), lane = tid & 63, wr = wid >> 2, wc = wid & 3, fr = lane & 15, fq = lane >> 4;
    const int K = g.K, nt = K / BK;
    unsigned voffA[2], voffB[2];
#pragma unroll
    for (int i = 0; i < 2; ++i) { int R, C; stage_rc(tid * 16 + i * 8192, R, C); const int Rb = Epi::PERM ? ((R & ~31) + perm32(R & 31)) : R;
        voffA[i] = (unsigned)(R * K + C) * 2u; voffB[i] = (unsigned)(Rb * K + C) * 2u; }
    const size_t kstep = (size_t)(BK * 2);
    const size_t hstep = (size_t)HALF * K * 2;
    const size_t tstep = 2 * hstep;
    const unsigned ldsw = (unsigned)wid * 1024u;
    const int aoff = lds_byte(wr * 64 + fr, fq * 8), boff = lds_byte(wc * 32 + fr, fq * 8);
#define PG8_SA(b, h) (((b) * 2 + (h)) * HTB)
#define PG8_SB(b, h) ((4 + (b) * 2 + (h)) * HTB)
#define PG8_STAGE(bufoff, gbase, voff) do { _Pragma("unroll") for (int _i = 0; _i < 2; ++_i) { unsigned _vo = (voff)[_i]; asm volatile("" : "+v"(_vo)); \
        __builtin_amdgcn_global_load_lds((const unsigned*)((const char*)(gbase) + _vo), (PG8_LAS unsigned*)(lds + (bufoff) + ldsw + _i * 8192), 16, 0, 0); } } while (0)
#define PG8_LDA(dst, b, h) do { _Pragma("unroll") for (int m = 0; m < 4; ++m) _Pragma("unroll") for (int k = 0; k < 2; ++k) dst[m][k] = *(const PG8_LAS bf16x8*)(lds + PG8_SA(b, h) + aoff + m * 2048 + k * 1024); } while (0)
#define PG8_LDB(dst, b, h) do { _Pragma("unroll") for (int n = 0; n < 2; ++n) _Pragma("unroll") for (int k = 0; k < 2; ++k) dst[n][k] = *(const PG8_LAS bf16x8*)(lds + PG8_SB(b, h) + boff + n * 2048 + k * 1024); } while (0)
#define PG8_MMA(ai, bj, At, Bt) do { __builtin_amdgcn_s_setprio(1); _Pragma("unroll") for (int m = 0; m < 4; ++m) _Pragma("unroll") for (int n = 0; n < 2; ++n) _Pragma("unroll") for (int k = 0; k < 2; ++k) \
        acc[ai][bj][m][n] = __builtin_amdgcn_mfma_f32_16x16x32_bf16(Bt[n][k], At[m][k], acc[ai][bj][m][n], 0, 0, 0); __builtin_amdgcn_s_setprio(0); } while (0)
#define PG8_WAIT_V(n) asm volatile("s_waitcnt vmcnt(" #n ")" ::: "memory")
#define PG8_WAIT_L(n) asm volatile("s_waitcnt lgkmcnt(" #n ")" ::: "memory")
#define PG8_BAR __builtin_amdgcn_s_barrier()
#define PG8_SCHED __builtin_amdgcn_sched_barrier(0)
    Unit cur, nxt; int ui = 0;
    if (!S.next(0, cur)) return;
    f32x4 acc[2][2][4][2];
#pragma unroll
    for (int a = 0; a < 2; ++a)
#pragma unroll
        for (int b = 0; b < 2; ++b)
#pragma unroll
            for (int m = 0; m < 4; ++m)
#pragma unroll
                for (int n = 0; n < 2; ++n) acc[a][b][m][n] = (f32x4){0.f, 0.f, 0.f, 0.f};
    bf16x8 At[4][2], B0[2][2], B1[2][2];
    const char* cA = (const char*)g.A + (size_t)cur.pm * tstep; const char* cB = (const char*)g.Bt + (size_t)cur.pn * tstep;
    S.a_ready(cur);
    if constexpr (SP2) {
        PG8_STAGE(PG8_SB(0, 0), cB, voffB); PG8_STAGE(PG8_SB(0, 1), cB + hstep, voffB); PG8_STAGE(PG8_SA(0, 0), cA, voffA); PG8_STAGE(PG8_SA(0, 1), cA + hstep, voffA);
        if (wr == 1) PG8_BAR;
        PG8_WAIT_V(2); PG8_BAR;
        PG8_STAGE(PG8_SB(1, 0), cB + kstep, voffB); PG8_STAGE(PG8_SA(1, 0), cA + kstep, voffA); PG8_STAGE(PG8_SB(1, 1), cB + hstep + kstep, voffB);
        PG8_WAIT_V(6); PG8_BAR;
    } else {
        PG8_STAGE(PG8_SB(0, 0), cB, voffB); PG8_STAGE(PG8_SA(0, 0), cA, voffA); PG8_STAGE(PG8_SB(0, 1), cB + hstep, voffB); PG8_STAGE(PG8_SA(0, 1), cA + hstep, voffA);
        if (wr == 1) PG8_BAR;
        PG8_WAIT_V(4); PG8_BAR;
        PG8_STAGE(PG8_SB(1, 0), cB + kstep, voffB); PG8_STAGE(PG8_SA(1, 0), cA + kstep, voffA); PG8_STAGE(PG8_SB(1, 1), cB + hstep + kstep, voffB);
        PG8_WAIT_V(6); PG8_BAR;
    }
    for (;;) {
        const bool has_next = S.next(ui + 1, nxt);
        const char* nA = has_next ? (const char*)g.A + (size_t)nxt.pm * tstep : cA; const char* nB = has_next ? (const char*)g.Bt + (size_t)nxt.pn * tstep : cB;
        for (int t = 0; t < nt; t += 2) {
            if constexpr (Epi::MID) { if (t == (nt >> 1)) E.mid(acc, cur, wr, wc, fr, fq); }
            const bool last = (t == nt - 2);
            const char* a1 = cA + (size_t)(t + 1) * kstep;
            const char* a2 = last ? nA : cA + (size_t)(t + 2) * kstep; const char* b2 = last ? nB : cB + (size_t)(t + 2) * kstep;
            const char* a3 = a2 + kstep; const char* b3 = b2 + kstep;
            if (last && has_next) S.a_ready(nxt);
            if constexpr (SP2) {
            PG8_LDB(B0, 0, 0); PG8_LDB(B1, 0, 1); PG8_SCHED; PG8_LDA(At, 0, 0); PG8_STAGE(PG8_SA(1, 1), a1 + hstep, voffA);
            PG8_WAIT_V(8); PG8_WAIT_L(0); PG8_BAR; PG8_MMA(0, 0, At, B0); PG8_MMA(0, 1, At, B1); PG8_BAR; PG8_SCHED;
            PG8_LDA(At, 0, 1); PG8_STAGE(PG8_SB(0, 0), b2, voffB); PG8_STAGE(PG8_SB(0, 1), b2 + hstep, voffB); PG8_STAGE(PG8_SA(0, 0), a2, voffA);
            PG8_WAIT_V(8); PG8_WAIT_L(0); PG8_BAR; PG8_MMA(1, 0, At, B0); PG8_MMA(1, 1, At, B1); PG8_BAR; PG8_SCHED;
            PG8_LDB(B0, 1, 0); PG8_LDB(B1, 1, 1); PG8_SCHED; PG8_LDA(At, 1, 0); PG8_STAGE(PG8_SA(0, 1), a2 + hstep, voffA);
            PG8_WAIT_V(8); PG8_WAIT_L(0); PG8_BAR; PG8_MMA(0, 0, At, B0); PG8_MMA(0, 1, At, B1); PG8_BAR; PG8_SCHED;
            PG8_LDA(At, 1, 1); PG8_STAGE(PG8_SB(1, 0), b3, voffB); PG8_STAGE(PG8_SB(1, 1), b3 + hstep, voffB); PG8_STAGE(PG8_SA(1, 0), a3, voffA);
            PG8_WAIT_V(8); PG8_WAIT_L(0); PG8_BAR; PG8_MMA(1, 0, At, B0); PG8_MMA(1, 1, At, B1); PG8_BAR; PG8_SCHED;
            } else {
            PG8_LDB(B0, 0, 0); PG8_SCHED; PG8_LDA(At, 0, 0); PG8_STAGE(PG8_SA(1, 1), a1 + hstep, voffA);
            PG8_WAIT_L(8); PG8_BAR; PG8_WAIT_L(0); PG8_MMA(0, 0, At, B0); PG8_BAR; PG8_SCHED;
            PG8_LDB(B1, 0, 1); PG8_STAGE(PG8_SB(0, 0), b2, voffB);
            PG8_BAR; PG8_WAIT_L(0); PG8_MMA(0, 1, At, B1); PG8_BAR;
            PG8_LDA(At, 0, 1); PG8_STAGE(PG8_SA(0, 0), a2, voffA);
            PG8_BAR; PG8_WAIT_L(0); PG8_MMA(1, 0, At, B0); PG8_BAR; PG8_SCHED;
            PG8_STAGE(PG8_SB(0, 1), b2 + hstep, voffB);
            PG8_WAIT_V(6); PG8_BAR; PG8_MMA(1, 1, At, B1); PG8_BAR;
            PG8_LDB(B0, 1, 0); PG8_SCHED; PG8_LDA(At, 1, 0); PG8_STAGE(PG8_SA(0, 1), a2 + hstep, voffA);
            PG8_WAIT_L(8); PG8_BAR; PG8_WAIT_L(0); PG8_MMA(0, 0, At, B0); PG8_BAR; PG8_SCHED;
            PG8_LDB(B1, 1, 1); PG8_STAGE(PG8_SB(1, 0), b3, voffB);
            PG8_BAR; PG8_WAIT_L(0); PG8_MMA(0, 1, At, B1); PG8_BAR;
            PG8_LDA(At, 1, 1); PG8_STAGE(PG8_SA(1, 0), a3, voffA);
            PG8_BAR; PG8_WAIT_L(0); PG8_MMA(1, 0, At, B0); PG8_BAR; PG8_SCHED;
            PG8_STAGE(PG8_SB(1, 1), b3 + hstep, voffB);
            PG8_WAIT_V(6); PG8_BAR; PG8_MMA(1, 1, At, B1); PG8_BAR;
            }
        }
        if constexpr (ALIGN_EPI) { if (wr == 0) PG8_BAR; }
        if constexpr (!Epi::AFTER_DRAIN) { E(acc, cur, wr, wc, fr, fq); S.done(cur); }
        if (!has_next) break;
#pragma unroll
        for (int a = 0; a < 2; ++a)
#pragma unroll
            for (int b = 0; b < 2; ++b)
#pragma unroll
                for (int m = 0; m < 4; ++m)
#pragma unroll
                    for (int n = 0; n < 2; ++n) acc[a][b][m][n] = (f32x4){0.f, 0.f, 0.f, 0.f};
        cur = nxt; cA = nA; cB = nB; ++ui;
        if constexpr (ALIGN_EPI) { if (wr == 1) PG8_BAR; }
    }
    PG8_WAIT_V(0);
    if constexpr (!ALIGN_EPI) { if (wr == 0) PG8_BAR; }
    PG8_BAR;
    if constexpr (Epi::AFTER_DRAIN) { E.fused(acc, cur, wr, wc, fr, fq, lds, wid, lane); S.done(cur); }
#undef PG8_SA
#undef PG8_SB
#undef PG8_STAGE
#undef PG8_LDA
#undef PG8_LDB
#undef PG8_MMA
#undef PG8_WAIT_V
#undef PG8_WAIT_L
#undef PG8_BAR
#undef PG8_SCHED
}
}
#include <hip/hip_bf16.h>
#include <cmath>
namespace attn_body {
using bf16=__hip_bfloat16;
using bf16x8=__attribute__((ext_vector_type(8)))short;
using s16x4=__attribute__((ext_vector_type(4)))short;
using f32x16=__attribute__((ext_vector_type(16)))float;
using u32x4=__attribute__((ext_vector_type(4)))unsigned;
constexpr int SEQ=4096,D=64,QP=512,KP=128,OP=1024;
constexpr int NW=8,QBLK=32,QB=QBLK*NW,KVBLK=64,NQB=SEQ/QB;
constexpr int ATTN_UNIT_ROWS=QB;
__device__ __forceinline__ int crow(int r,int hi){return (r&3)+8*(r>>2)+4*hi;}
#define SBAR() __builtin_amdgcn_sched_barrier(0)
__device__ __forceinline__ void cmask(f32x16&p0,f32x16&p1,int jb,int qrel,int hi){
  const float NEG=-INFINITY; int kb=64*jb+4*hi;
  #pragma unroll
  for(int r=0;r<16;++r){int kv=kb+(r&3)+8*(r>>2); if(kv>qrel)p0[r]=NEG; if(kv+32>qrel)p1[r]=NEG;}
}

constexpr int NSLOT=3, SLOTB=8192;
constexpr int LDS_K=0, LDS_V=NSLOT*SLOTB, LDS_WS=2*NSLOT*SLOTB, LDS_OST=LDS_WS+NW*64*4, LDS_BYTES=LDS_OST+NW*4096;
constexpr float C2=0.125f*1.4426950408889634f;
__device__ __forceinline__ void glds16(const void*gsrc,unsigned lds_dst){unsigned keep;
  asm volatile("s_mov_b32 %0, m0\n\ts_mov_b32 m0, %2\n\ts_nop 0\n\tglobal_load_lds_dwordx4 %1, off\n\ts_mov_b32 m0, %0":"=&s"(keep):"v"(gsrc),"s"(lds_dst):"memory");}
__device__ __forceinline__ float max3f(float a,float b,float c){float r;asm("v_max3_f32 %0, %1, %2, %3":"=v"(r):"v"(a),"v"(b),"v"(c));return r;}
__device__ __forceinline__ float max2f(float a,float b){float r;asm("v_max_f32_e32 %0, %1, %2":"=v"(r):"v"(a),"v"(b));return r;}
__device__ __forceinline__ float fadd_s(float a,float b){float r;asm("v_add_f32_e32 %0, %1, %2":"=v"(r):"v"(a),"v"(b));return r;}
__device__ __forceinline__ float fsub_s(float a,float b){float r;asm("v_sub_f32_e32 %0, %1, %2":"=v"(r):"v"(a),"v"(b));return r;}
typedef float f32x2_t __attribute__((ext_vector_type(2))); typedef __bf16 bf16x2_t __attribute__((ext_vector_type(2)));
__device__ __forceinline__ unsigned cvtpk_s(float lo,float hi){f32x2_t v={lo,hi};bf16x2_t b=__builtin_convertvector(v,bf16x2_t);return __builtin_bit_cast(unsigned,b);}
#define WAIT_BAR(N) asm volatile("s_waitcnt vmcnt(" #N ") lgkmcnt(0)\n\ts_barrier":::"memory")

__device__ __forceinline__ void qkt(f32x16&p0,f32x16&p1,const char*Kslot,const bf16x8*qr,const f32x16&negm,int r32,int hi){
  const char*kb=Kslot+hi*1024+r32*16;
  #pragma unroll
  for(int d0=0;d0<4;++d0){
    const bf16x8 b0=*reinterpret_cast<const bf16x8*>(kb+d0*2048);
    const bf16x8 b1=*reinterpret_cast<const bf16x8*>(kb+d0*2048+512);
    if(d0==0){p0=__builtin_amdgcn_mfma_f32_32x32x16_bf16(b0,qr[0],negm,0,0,0);p1=__builtin_amdgcn_mfma_f32_32x32x16_bf16(b1,qr[0],negm,0,0,0);}
    else{p0=__builtin_amdgcn_mfma_f32_32x32x16_bf16(b0,qr[d0],p0,0,0,0);p1=__builtin_amdgcn_mfma_f32_32x32x16_bf16(b1,qr[d0],p1,0,0,0);}}
}
typedef __attribute__((address_space(3))) const char* lds_cptr;
typedef short v4i16_t __attribute__((ext_vector_type(4)));
__device__ __forceinline__ void kload8(bf16x8*kf,lds_cptr kp){
  kf[0]=*(const __attribute__((address_space(3))) bf16x8*)(kp);      kf[1]=*(const __attribute__((address_space(3))) bf16x8*)(kp+512);
  kf[2]=*(const __attribute__((address_space(3))) bf16x8*)(kp+2048); kf[3]=*(const __attribute__((address_space(3))) bf16x8*)(kp+2560);
  kf[4]=*(const __attribute__((address_space(3))) bf16x8*)(kp+4096); kf[5]=*(const __attribute__((address_space(3))) bf16x8*)(kp+4608);
  kf[6]=*(const __attribute__((address_space(3))) bf16x8*)(kp+6144); kf[7]=*(const __attribute__((address_space(3))) bf16x8*)(kp+6656);
}
__device__ __forceinline__ void kload2(bf16x8*kf,lds_cptr kp,int j){ kf[2*j]=*(const __attribute__((address_space(3))) bf16x8*)(kp+j*2048); kf[2*j+1]=*(const __attribute__((address_space(3))) bf16x8*)(kp+j*2048+512); }
__device__ __forceinline__ s16x4 vtr(lds_cptr p){ return __builtin_bit_cast(s16x4,__builtin_amdgcn_ds_read_tr16_b64_v4i16((__attribute__((address_space(3))) v4i16_t*)p)); }
__device__ __forceinline__ float rowmax(const f32x16&p0,const f32x16&p1){
  float a=max3f(p0[0],p0[1],p1[0]),b=max3f(p0[2],p0[3],p1[1]);a=max3f(a,p1[2],p1[3]);
  #pragma unroll
  for(int r=4;r<16;r+=4){a=max3f(a,p0[r],p0[r+1]);b=max3f(b,p0[r+2],p0[r+3]);a=max3f(a,p1[r],p1[r+1]);b=max3f(b,p1[r+2],p1[r+3]);}
  const float m=max2f(a,b);
  auto rr=__builtin_amdgcn_permlane32_swap(__float_as_uint(m),__float_as_uint(m),false,false);
  return max2f(__uint_as_float(rr[0]),__uint_as_float(rr[1]));
}
__device__ __forceinline__ void pv(f32x16*o,int vb,bf16x8 pa0,bf16x8 pa1,bf16x8 pa2,bf16x8 pa3){
  #pragma unroll
  for(int d0=0;d0<2;++d0){s16x4 lo[4],hi[4];
    #pragma unroll
    for(int ks=0;ks<4;++ks){
      asm volatile("ds_read_b64_tr_b16 %0,%1 offset:%c2":"=&v"(lo[ks]):"v"(vb),"i"(d0*4096+ks*1024):"memory");
      asm volatile("ds_read_b64_tr_b16 %0,%1 offset:%c2":"=&v"(hi[ks]):"v"(vb),"i"(d0*4096+ks*1024+512):"memory");}
    asm volatile("s_waitcnt lgkmcnt(0)":::"memory");SBAR();
    #define PK(k) (bf16x8){lo[k][0],lo[k][1],lo[k][2],lo[k][3],hi[k][0],hi[k][1],hi[k][2],hi[k][3]}
    o[d0]=__builtin_amdgcn_mfma_f32_32x32x16_bf16(pa0,PK(0),o[d0],0,0,0);
    o[d0]=__builtin_amdgcn_mfma_f32_32x32x16_bf16(pa1,PK(1),o[d0],0,0,0);
    o[d0]=__builtin_amdgcn_mfma_f32_32x32x16_bf16(pa2,PK(2),o[d0],0,0,0);
    o[d0]=__builtin_amdgcn_mfma_f32_32x32x16_bf16(pa3,PK(3),o[d0],0,0,0);
    #undef PK
  }
}

#ifndef ATTN_STORE16
#define ATTN_STORE16(p,v) (*(u32x4*)(p)=(v))
#endif
template<int THRL> __device__ __forceinline__ void attn_unit(int b,int h,int qb,const bf16*Q,const bf16*__restrict__ K,const bf16*__restrict__ V,bf16*O,float*SSQ,char*shm){
  int tid_=threadIdx.x; asm volatile("":"+v"(tid_));
  const int tid=tid_,lane=tid&63,r32=lane&31,hi=lane>>5; const int wid=__builtin_amdgcn_readfirstlane(tid>>6);
  const long rowbase=(long)b*SEQ; const int q0=qb*QB;
  const bf16*Qw=Q+(rowbase+q0+wid*QBLK)*QP+h*D;
  const bf16*Kh=K+rowbase*KP+(h>>2)*D,*Vh=V+rowbase*KP+(h>>2)*D;
  const unsigned lds0=(unsigned)(uintptr_t)shm;
  float*wsf=(float*)(shm+LDS_WS)+wid*64;
  const bf16*ksrc=Kh+(long)lane*KP+wid*8;
  const bf16*vsrc=Vh+(long)(16*(wid&3)+(lane>>2))*KP+(wid>>2)*32+(lane&3)*8;
  const unsigned kdst=lds0+LDS_K+wid*1024, vdst=lds0+LDS_V+wid*1024;
  #define DMA_K(t,slot) glds16(ksrc+(long)(t)*KVBLK*KP,(unsigned)__builtin_amdgcn_readfirstlane(kdst+(slot)))
  #define DMA_V(t,slot) glds16(vsrc+(long)(t)*KVBLK*KP,(unsigned)__builtin_amdgcn_readfirstlane(vdst+(slot)))
  const int vb0=(int)(lds0+LDS_V)+((lane>>4)&1)*32+(lane&3)*8+(4*hi+((lane&15)>>2))*64;
  const char*Kbase=shm+LDS_K; bf16x8 kf[8];
  const lds_cptr shm3=(lds_cptr)shm; const lds_cptr kp0=shm3+LDS_K+hi*1024+r32*16; const lds_cptr vp0=shm3+LDS_V+((lane>>4)&1)*32+(lane&3)*8+(4*hi+((lane&15)>>2))*64;
  const int NT=SEQ/KVBLK;
  DMA_K(0,0);DMA_V(0,0);DMA_K(1,SLOTB);
  bf16x8 qr[4];
  #pragma unroll
  for(int d0=0;d0<4;++d0)qr[d0]=*reinterpret_cast<const bf16x8*>(&Qw[(long)r32*QP+d0*16+hi*8]);
  float mhat=0.f,l_reg=0.f;f32x16 o[2];o[0]=f32x16{};o[1]=f32x16{};f32x16 negm=f32x16{};asm volatile("":"+v"(negm));
  #define CMASK(P0,P1,t) do{}while(0)
  bool resc=false;
  #define START(P0,P1) do{ const float rm=rowmax(P0,P1); resc=false; \
    { const float dl=rm; mhat=fadd_s(mhat,dl); \
      _Pragma("unroll") for(int r=0;r<16;++r){P0[r]=fsub_s(P0[r],dl);P1[r]=fsub_s(P1[r],dl);} \
      _Pragma("unroll") for(int r=0;r<16;++r)negm[r]=-mhat; asm volatile("":"+v"(negm)); } \
    _Pragma("unroll") for(int r=0;r<16;++r)P0[r]=__builtin_amdgcn_exp2f(P0[r]); }while(0)
  #define RESC() do{ if(resc){ asm volatile("s_waitcnt lgkmcnt(0)":::"memory"); \
      _Pragma("unroll") for(int d_=0;d_<2;++d_) _Pragma("unroll") for(int r=0;r<16;++r)o[d_][r]*=wsf[crow(r,hi)]; } }while(0)
  f32x16 pA0,pA1,pB0,pB1;
  int sl_prev=0,sl_cur=0,sl_next=SLOTB;
  #define ROT() do{sl_prev=sl_cur;sl_cur=sl_next;sl_next=(sl_next==(NSLOT-1)*SLOTB)?0:sl_next+SLOTB;}while(0)
  DMA_K(2,2*SLOTB);
  WAIT_BAR(3);
  qkt(pA0,pA1,Kbase,qr,negm,r32,hi);asm volatile("s_nop 15\n\ts_nop 7":"+v"(pA0),"+v"(pA1));CMASK(pA0,pA1,0);
  START(pA0,pA1);
  _Pragma("unroll") for(int r=0;r<16;++r)pA1[r]=__builtin_amdgcn_exp2f(pA1[r]);
  WAIT_BAR(0);
  DMA_K(3,0);DMA_V(1,SLOTB);
  ROT();
  kload8(kf,kp0+sl_cur);
  WAIT_BAR(2);
  s16x4 vlo[8],vhi[8]; u32x4 pw0,pw1,pw2,pw3;
  #define PKW(P,B) cvtpk_s(P[B],P[B+1])
  #define PAF(k) __builtin_bit_cast(bf16x8,pw##k)
  #define VFR(i) (bf16x8){vlo[i][0],vlo[i][1],vlo[i][2],vlo[i][3],vhi[i][0],vhi[i][1],vhi[i][2],vhi[i][3]}
  #define PIN(x) asm volatile("":"+v"(x))
  #define MX3(a,b,c) __builtin_fmaxf(__builtin_fmaxf((a),(b)),(c))
  #define GAPA(MF,A0,A1,A2,A3,W0,W1,PW) do{ MF; sacc+=A0; sacc+=A1; sacc+=A2; sacc+=A3; PIN(sacc); W0; W1; PIN(PW); SBAR(); }while(0)
  #define EX(v) __builtin_amdgcn_exp2f(v)
  #define GAPB(MF,X,B) do{ MF; X[B]=EX(X[B]); X[B+1]=EX(X[B+1]); X[B+2]=EX(X[B+2]); X[B+3]=EX(X[B+3]); PIN(X); SBAR(); }while(0)
  #define VRD(i) do{ vlo[i]=vtr(vp_+(((i)>>2)*4096+((i)&3)*1024)); vhi[i]=vtr(vp_+(((i)>>2)*4096+((i)&3)*1024+512)); }while(0)
  #define KRD(G,j) do{ if(G){ kload2(kf,kp0+sl_next,j); SBAR(); } }while(0)
  #define STEP(C0,C1,P0,P1,t,GK,GV,GL) do{ SBAR(); \
    const lds_cptr vp_=vp0+sl_prev; \
    VRD(0); SBAR(); float sacc=(P0[0]+P0[1]); \
    GAPA(C0=__builtin_amdgcn_mfma_f32_32x32x16_bf16(kf[0],qr[0],negm,0,0,0), P0[2],P0[3],P0[4],P0[5],     pw0[0]=PKW(P0,0), pw0[1]=PKW(P0,2), pw0); \
    VRD(4); SBAR(); GAPA(C1=__builtin_amdgcn_mfma_f32_32x32x16_bf16(kf[1],qr[0],negm,0,0,0), P0[6],P0[7],P0[8],P0[9],     pw0[2]=PKW(P0,4), pw0[3]=PKW(P0,6), pw0); \
    VRD(1); SBAR(); GAPA(C0=__builtin_amdgcn_mfma_f32_32x32x16_bf16(kf[2],qr[1],C0,0,0,0),   P0[10],P0[11],P0[12],P0[13], pw1[0]=PKW(P0,8), pw1[1]=PKW(P0,10), pw1); \
    VRD(5); SBAR(); GAPA(C1=__builtin_amdgcn_mfma_f32_32x32x16_bf16(kf[3],qr[1],C1,0,0,0),   P0[14],P0[15],P1[0],P1[1],   pw1[2]=PKW(P0,12),pw1[3]=PKW(P0,14), pw1); \
    VRD(2); SBAR(); GAPA(C0=__builtin_amdgcn_mfma_f32_32x32x16_bf16(kf[4],qr[2],C0,0,0,0),   P1[2],P1[3],P1[4],P1[5],     pw2[0]=PKW(P1,0), pw2[1]=PKW(P1,2), pw2); \
    VRD(6); SBAR(); GAPA(C1=__builtin_amdgcn_mfma_f32_32x32x16_bf16(kf[5],qr[2],C1,0,0,0),   P1[6],P1[7],P1[8],P1[9],     pw2[2]=PKW(P1,4), pw2[3]=PKW(P1,6), pw2); \
    VRD(3); SBAR(); GAPA(C0=__builtin_amdgcn_mfma_f32_32x32x16_bf16(kf[6],qr[3],C0,0,0,0),   P1[10],P1[11],P1[12],P1[13], pw3[0]=PKW(P1,8), pw3[1]=PKW(P1,10), pw3); \
    VRD(7); SBAR(); GAPA(C1=__builtin_amdgcn_mfma_f32_32x32x16_bf16(kf[7],qr[3],C1,0,0,0),   P1[14],P1[15],0.f,0.f,       pw3[2]=PKW(P1,12),pw3[3]=PKW(P1,14), pw3); \
    l_reg+=sacc; \
    if(GK){DMA_K((t)+3,sl_cur);} if(GV){DMA_V((t)+1,sl_next);} \
    CMASK(C0,C1,t); \
    { float a=MX3(C0[0],C0[1],C1[0]),b=MX3(C0[2],C0[3],C1[1]); a=MX3(a,C1[2],C1[3]); \
      _Pragma("unroll") for(int r=4;r<16;r+=4){a=MX3(a,C0[r],C0[r+1]);b=MX3(b,C0[r+2],C0[r+3]);a=MX3(a,C1[r],C1[r+1]);b=MX3(b,C1[r+2],C1[r+3]);} \
      float rm=__builtin_fmaxf(a,b); { auto rr=__builtin_amdgcn_permlane32_swap(__float_as_uint(rm),__float_as_uint(rm),false,false); rm=__builtin_fmaxf(__uint_as_float(rr[0]),__uint_as_float(rr[1])); } \
      resc=false; \
      if(__builtin_expect(__any(rm>(float)THRL),0)){ const float dl=__builtin_fmaxf(rm,0.f); mhat+=dl; \
        _Pragma("unroll") for(int r=0;r<16;++r){C0[r]-=dl;C1[r]-=dl;} \
        _Pragma("unroll") for(int r=0;r<16;++r)negm[r]=-mhat; asm volatile("":"+v"(negm)); \
        const float f=__builtin_amdgcn_exp2f(-dl); l_reg*=f; if(hi==0)wsf[r32]=f; resc=true; } } \
    SBAR(); \
    GAPB(o[0]=__builtin_amdgcn_mfma_f32_32x32x16_bf16(PAF(0),VFR(0),o[0],0,0,0), C0,0); \
    GAPB(o[1]=__builtin_amdgcn_mfma_f32_32x32x16_bf16(PAF(0),VFR(4),o[1],0,0,0), C0,4); \
    KRD(GL,0); GAPB(o[0]=__builtin_amdgcn_mfma_f32_32x32x16_bf16(PAF(1),VFR(1),o[0],0,0,0), C0,8); \
    KRD(GL,1); GAPB(o[1]=__builtin_amdgcn_mfma_f32_32x32x16_bf16(PAF(1),VFR(5),o[1],0,0,0), C0,12); \
    KRD(GL,2); GAPB(o[0]=__builtin_amdgcn_mfma_f32_32x32x16_bf16(PAF(2),VFR(2),o[0],0,0,0), C1,0); \
    KRD(GL,3); GAPB(o[1]=__builtin_amdgcn_mfma_f32_32x32x16_bf16(PAF(2),VFR(6),o[1],0,0,0), C1,4); \
    GAPB(o[0]=__builtin_amdgcn_mfma_f32_32x32x16_bf16(PAF(3),VFR(3),o[0],0,0,0), C1,8); \
    GAPB(o[1]=__builtin_amdgcn_mfma_f32_32x32x16_bf16(PAF(3),VFR(7),o[1],0,0,0), C1,12); \
    }while(0)
  int t=1;
  #undef CMASK
  #define CMASK(P0,P1,t) do{}while(0)
  for(;t+5<NT;t+=2){
    STEP(pB0,pB1,pA0,pA1,t,true,true,true);     WAIT_BAR(2); RESC(); ROT();
    STEP(pA0,pA1,pB0,pB1,t+1,true,true,true);   WAIT_BAR(2); RESC(); ROT();
  }
  #undef CMASK
  #define CMASK(P0,P1,t) do{}while(0)
  #define ENDW(tt) do{ if((tt)+3<NT){WAIT_BAR(2);} else if((tt)+2<NT){WAIT_BAR(1);} else {WAIT_BAR(0);} }while(0)
  for(;t+1<NT;t+=2){
    STEP(pB0,pB1,pA0,pA1,t,(t+3<NT),(t+1<NT),(t+1<NT));       ENDW(t);   RESC(); ROT();
    STEP(pA0,pA1,pB0,pB1,t+1,(t+4<NT),(t+2<NT),(t+2<NT));     ENDW(t+1); RESC(); ROT();
  }
  STEP(pB0,pB1,pA0,pA1,NT-1,false,false,false); RESC();
  { float sacc=pB0[0]+pB0[1]; _Pragma("unroll") for(int r=2;r<16;++r)sacc+=pB0[r]; _Pragma("unroll") for(int r=0;r<16;++r)sacc+=pB1[r]; l_reg+=sacc;
    pw0=(u32x4){PKW(pB0,0),PKW(pB0,2),PKW(pB0,4),PKW(pB0,6)};pw1=(u32x4){PKW(pB0,8),PKW(pB0,10),PKW(pB0,12),PKW(pB0,14)};pw2=(u32x4){PKW(pB1,0),PKW(pB1,2),PKW(pB1,4),PKW(pB1,6)};pw3=(u32x4){PKW(pB1,8),PKW(pB1,10),PKW(pB1,12),PKW(pB1,14)};
    SBAR(); pv(o,vb0+sl_cur,PAF(0),PAF(1),PAF(2),PAF(3)); }
  #undef PKW
  #undef PAF
  #undef VFR
  #undef PIN
  #undef MX3
  #undef GAPA
  #undef GAPB
  #undef EX
  #undef VRD
  #undef KRD
  #undef STEP
  #undef ENDW
  {auto rr=__builtin_amdgcn_permlane32_swap(__float_as_uint(l_reg),__float_as_uint(l_reg),false,false);l_reg=__uint_as_float(rr[0])+__uint_as_float(rr[1]);}
  if(hi==0)wsf[32+r32]=l_reg;asm volatile("s_waitcnt lgkmcnt(0)":::"memory");
  float rli[16];
  #pragma unroll
  for(int r=0;r<16;++r)rli[r]=__builtin_amdgcn_rcpf(wsf[32+crow(r,hi)]);
  bf16*Ow=O+(rowbase+q0+wid*QBLK)*OP+h*D; float*SSw=SSQ+(rowbase+q0+wid*QBLK)*8+h;
  { bf16*stg=(bf16*)(shm+LDS_OST)+wid*2048;
    #pragma unroll
    for(int r=0;r<16;++r){const int orow=crow(r,hi);
      #pragma unroll
      for(int d0=0;d0<2;++d0)stg[orow*64+d0*32+r32]=__float2bfloat16(o[d0][r]*rli[r]);}
    asm volatile("s_waitcnt lgkmcnt(0)":::"memory");
    #pragma unroll
    for(int i=0;i<4;++i){const int row=i*8+(lane>>3),ch=lane&7; const u32x4 v=*(const u32x4*)(stg+row*64+ch*8); ATTN_STORE16(Ow+(long)row*OP+ch*8,v);
      float sq=0.f;
      #pragma unroll
      for(int j=0;j<4;++j){const float lo=__uint_as_float(v[j]<<16),hi2=__uint_as_float(v[j]&0xffff0000u); sq+=lo*lo+hi2*hi2;}
      sq+=__shfl_xor(sq,1);sq+=__shfl_xor(sq,2);sq+=__shfl_xor(sq,4);
      if(ch==0)SSw[(long)row*8]=sq;} }
  asm volatile("s_waitcnt lgkmcnt(0)\n\ts_barrier":::"memory");
  #undef DMA_K
  #undef DMA_V
  #undef CMASK
  #undef START
  #undef RESC
  #undef ROT
}
constexpr int ATTN_LDS_BYTES=LDS_BYTES;
#undef SBAR
#undef WAIT_BAR
}

constexpr int BATCH = 4, SEQ = 4096, DM = 1024, DEPTH = 4, FF = 4096, INW = 2304;
constexpr int M = BATCH * SEQ;
constexpr size_t MiB = 1u << 20;
constexpr size_t WS_COSA = 0, WS_SINA = 4096, WS_COSB = 8192, WS_SINB = 8192 + 131072;
constexpr size_t WS_BAR = 524288, BAR_BYTES = 16384;
constexpr size_t WS_SS = 1 * MiB;
constexpr size_t WS_W = 3 * MiB;
constexpr size_t W_LAYER = 4718592 + 2 * MiB + 8 * MiB + 8 * MiB;
constexpr size_t WS_XB = 93 * MiB;
constexpr size_t WS_H = 125 * MiB;
constexpr size_t WS_QA = 125 * MiB, WS_KA = 141 * MiB, WS_VA = 145 * MiB, WS_QB = 149 * MiB, WS_KB = 165 * MiB, WS_VB = 181 * MiB, WS_Y = 197 * MiB;
constexpr size_t WS_END = 253 * MiB;
static_assert(WS_W + 4 * W_LAYER <= WS_XB, "ws map");
constexpr int LDS_BYTES = 139264;

typedef unsigned short bf16_t;
typedef short bf16x8 __attribute__((ext_vector_type(8)));
typedef short s16x4 __attribute__((ext_vector_type(4)));
typedef float f32x4 __attribute__((ext_vector_type(4)));
typedef float f32x16 __attribute__((ext_vector_type(16)));
typedef unsigned u32x2 __attribute__((ext_vector_type(2)));
typedef unsigned u32x4 __attribute__((ext_vector_type(4)));
#define LAS __attribute__((address_space(3)))

struct Params {
    const float* x; const float* norm1; const float* w_in; const float* q_norm; const float* k_norm; const float* out_norm_a; const float* out_norm_b;
    const float* w_out; const float* norm2; const float* w_mlp_in; const float* w_mlp_out; const float* final_norm;
    float* out; unsigned char* ws;
    double frev[24];
};

__device__ __forceinline__ unsigned f2bf(float f) { unsigned u = __builtin_bit_cast(unsigned, f); return (u + 0x7fffu + ((u >> 16) & 1u)) >> 16; }
__device__ __forceinline__ unsigned pk2(float lo, float hi) { return f2bf(lo) | (f2bf(hi) << 16); }
__device__ __forceinline__ float wave_sum(float v) {
#pragma unroll
    for (int o = 1; o < 64; o <<= 1) v += __shfl_xor(v, o);
    return v;
}

__device__ __forceinline__ void transpose_item(const float* W, int K, int N, bf16_t* WT, int k0, int n0, int dst_row0, const float* g0, LAS float* scr, int lane) {
    float wv[32];
#pragma unroll
    for (int i = 0; i < 32; ++i) wv[i] = __builtin_nontemporal_load(W + (size_t)(k0 + 2 * i + (lane >> 5)) * N + n0 + (lane & 31));
    float gv = 1.f; if (g0) gv = g0[lane];
#pragma unroll
    for (int i = 0; i < 32; ++i) { const int kk = 2 * i + (lane >> 5); const float gk = __shfl(gv, kk); scr[kk * 33 + (lane & 31)] = wv[i] * gk; }
    asm volatile("s_waitcnt lgkmcnt(0)" ::: "memory");
    const int c = lane & 7;
#pragma unroll
    for (int j = 0; j < 4; ++j) { const int n = (lane >> 3) + 8 * j; const LAS float* s = scr + (8 * c) * 33 + n;
        u32x4 o; o.x = pk2(s[0 * 33], s[1 * 33]); o.y = pk2(s[2 * 33], s[3 * 33]); o.z = pk2(s[4 * 33], s[5 * 33]); o.w = pk2(s[6 * 33], s[7 * 33]);
        *(u32x4*)(WT + (size_t)(dst_row0 + n) * K + k0 + 8 * c) = o; }
    asm volatile("s_waitcnt lgkmcnt(0)" ::: "memory");
}

__device__ __forceinline__ s16x4 vtr(const LAS char* p) { typedef short v4i16_t __attribute__((ext_vector_type(4))); return __builtin_bit_cast(s16x4, __builtin_amdgcn_ds_read_tr16_b64_v4i16((LAS v4i16_t*)p)); }
__device__ __forceinline__ unsigned cvtpk(float lo, float hi) { typedef float f2 __attribute__((ext_vector_type(2))); typedef __bf16 b2 __attribute__((ext_vector_type(2))); f2 v = {lo, hi}; b2 b = __builtin_convertvector(v, b2); return __builtin_bit_cast(unsigned, b); }

__device__ __forceinline__ void softmax_block(f32x16& s, float& m, float& l, f32x16 (&o)[2], bool first, bf16x8 (&pf)[2]) {
    float rm = s[0];
#pragma unroll
    for (int r = 1; r < 16; ++r) rm = fmaxf(rm, s[r]);
    rm = fmaxf(rm, __shfl_xor(rm, 32));
    const bool upd = first || (rm - m > 6.0f);
    if (__any(upd)) {
        const float mn = upd ? fmaxf(rm, -64.0f) : m;
        const float alpha = __builtin_amdgcn_exp2f(m - mn);
        m = mn; l *= alpha;
#pragma unroll
        for (int r = 0; r < 16; ++r) { o[0][r] *= alpha; o[1][r] *= alpha; }
    }
    float sum = 0.f;
#pragma unroll
    for (int r = 0; r < 16; ++r) { s[r] = __builtin_amdgcn_exp2f(s[r] - m); sum += s[r]; }
    l += sum;
    u32x4 w0, w1;
    w0.x = cvtpk(s[0], s[1]); w0.y = cvtpk(s[2], s[3]); w0.z = cvtpk(s[4], s[5]); w0.w = cvtpk(s[6], s[7]);
    w1.x = cvtpk(s[8], s[9]); w1.y = cvtpk(s[10], s[11]); w1.z = cvtpk(s[12], s[13]); w1.w = cvtpk(s[14], s[15]);
    pf[0] = __builtin_bit_cast(bf16x8, w0); pf[1] = __builtin_bit_cast(bf16x8, w1);
}

__device__ __forceinline__ void attn_store(f32x16 (&o)[2], float l, bf16_t* yrow  , float* ssrow, int h) {
    const float lt = l + __shfl_xor(l, 32);
    const float inv = 1.0f / lt;
    float q = 0.f;
#pragma unroll
    for (int db = 0; db < 2; ++db)
#pragma unroll
        for (int g = 0; g < 4; ++g) {
            const float a = o[db][4 * g] * inv, b = o[db][4 * g + 1] * inv, c = o[db][4 * g + 2] * inv, d = o[db][4 * g + 3] * inv;
            q += (a * a + b * b) + (c * c + d * d);
            u32x2 w; w.x = cvtpk(a, b); w.y = cvtpk(c, d);
            *(u32x2*)(yrow + 32 * db + 8 * g + 4 * h) = w;
        }
    q += __shfl_xor(q, 32);
    if (h == 0) *ssrow = q;
}

template <int NQ>
__device__ __forceinline__ void attn_a_wave(const bf16_t* QA, const bf16_t* KA, const bf16_t* VA, bf16_t* Y, float* ssa, int b, int head, int row0, LAS char* vst, int lane) {
    const int q = lane & 31, h = lane >> 5, kvh = head >> 2;
    bf16x8 qf[NQ][4];
#pragma unroll
    for (int nq = 0; nq < NQ; ++nq)
#pragma unroll
        for (int ds = 0; ds < 4; ++ds) qf[nq][ds] = *(const bf16x8*)(QA + (size_t)(b * SEQ + row0 + 32 * nq + q) * 512 + head * 64 + 16 * ds + 8 * h);
    f32x16 o[NQ][2]; float m[NQ], l[NQ];
#pragma unroll
    for (int nq = 0; nq < NQ; ++nq) { m[nq] = 0.f; l[nq] = 0.f;
#pragma unroll
        for (int r = 0; r < 16; ++r) { o[nq][0][r] = 0.f; o[nq][1][r] = 0.f; } }
    const bf16_t* Kp = KA + (size_t)(b * SEQ + q) * 128 + kvh * 64 + 8 * h;
    const bf16_t* Vp = VA + (size_t)(b * SEQ + (lane >> 3)) * 128 + kvh * 64 + (lane & 7) * 8;
    const int vw_off = (lane >> 3) * 128 + (((lane & 7) * 16) ^ (((lane >> 4) & 1) << 6));
    const int sw = (lane >> 3) & 1;
    const int trb = (4 * h + ((lane & 15) >> 2)) * 128 + 32 * ((lane >> 4) & 1) + 8 * (lane & 3);
    const LAS char* tr0 = vst + trb + 64 * sw;
    const LAS char* tr1 = vst + trb + 64 * (1 - sw);
    bf16x8 kn[4], vn[4];
#pragma unroll
    for (int i = 0; i < 4; ++i) { kn[i] = *(const bf16x8*)(Kp + 16 * i); vn[i] = *(const bf16x8*)(Vp + (size_t)(8 * i) * 128); }
    for (int kb = 0; kb < SEQ / 32; ++kb) {
        bf16x8 kf[4];
#pragma unroll
        for (int i = 0; i < 4; ++i) { kf[i] = kn[i]; *(LAS bf16x8*)(vst + vw_off + i * 1024) = vn[i]; }
        if (kb + 1 < SEQ / 32) {
            const bf16_t* kp2 = Kp + (size_t)(kb + 1) * 32 * 128; const bf16_t* vp2 = Vp + (size_t)(kb + 1) * 32 * 128;
#pragma unroll
            for (int i = 0; i < 4; ++i) { kn[i] = *(const bf16x8*)(kp2 + 16 * i); vn[i] = *(const bf16x8*)(vp2 + (size_t)(8 * i) * 128); }
        }
        bf16x8 pf[NQ][2];
#pragma unroll
        for (int nq = 0; nq < NQ; ++nq) {
            f32x16 s;
#pragma unroll
            for (int r = 0; r < 16; ++r) s[r] = 0.f;
#pragma unroll
            for (int ds = 0; ds < 4; ++ds) s = __builtin_amdgcn_mfma_f32_32x32x16_bf16(kf[ds], qf[nq][ds], s, 0, 0, 0);
            softmax_block(s, m[nq], l[nq], o[nq], kb == 0, pf[nq]);
        }
#pragma unroll
        for (int s2 = 0; s2 < 2; ++s2)
#pragma unroll
            for (int db = 0; db < 2; ++db) {
                const LAS char* tp = (db == 0 ? tr0 : tr1) + s2 * 2048;
                const s16x4 lo = vtr(tp), hi = vtr(tp + 1024);
                const bf16x8 vf = (bf16x8){lo[0], lo[1], lo[2], lo[3], hi[0], hi[1], hi[2], hi[3]};
#pragma unroll
                for (int nq = 0; nq < NQ; ++nq) o[nq][db] = __builtin_amdgcn_mfma_f32_32x32x16_bf16(vf, pf[nq][s2], o[nq][db], 0, 0, 0);
            }
    }
#pragma unroll
    for (int nq = 0; nq < NQ; ++nq) {
        const size_t row = (size_t)(b * SEQ + row0 + 32 * nq + q);
        attn_store(o[nq], l[nq], Y + row * 1024 + head * 64, ssa + row * 8 + head, h);
    }
}

__device__ __forceinline__ void attn_b_wave(const bf16_t* QB, const bf16_t* KB, const bf16_t* VB, bf16_t* Y, float* ssb, int b, int head, int c, int r, LAS char* vst, int lane) {
    const int q = lane & 31, h = lane >> 5;
    const int qp = 512 * c + r + 16 * q;
    bf16x8 qf[4];
#pragma unroll
    for (int ds = 0; ds < 4; ++ds) qf[ds] = *(const bf16x8*)(QB + (size_t)(b * SEQ + qp) * 512 + head * 64 + 16 * ds + 8 * h);
    f32x16 o[2]; float m = 0.f, l = 0.f;
#pragma unroll
    for (int rr = 0; rr < 16; ++rr) { o[0][rr] = 0.f; o[1][rr] = 0.f; }
    const bf16_t* Kb = KB + (size_t)(b * SEQ) * 512 + head * 64 + (lane & 7) * 8;
    const bf16_t* Vb = VB + (size_t)(b * SEQ) * 512 + head * 64 + (lane & 7) * 8;
    const int vw_off = (lane >> 3) * 128 + (((lane & 7) * 16) ^ (((lane >> 4) & 1) << 6));
    const int kw_off = 4096 + (lane >> 3) * 128 + (((lane & 7) ^ ((lane >> 4) & 7)) << 4);
    const int kr_base = 4096 + q * 128, kr_sw = (q >> 1) & 7;
    const int sw = (lane >> 3) & 1;
    const int trb = (4 * h + ((lane & 15) >> 2)) * 128 + 32 * ((lane >> 4) & 1) + 8 * (lane & 3);
    const LAS char* tr0 = vst + trb + 64 * sw;
    const LAS char* tr1 = vst + trb + 64 * (1 - sw);
    const int base = 512 * c + r;
#define BLK_INFO(i, dil, ks) do { if ((i) < 5) { dil = 16; ks = base - 1024 + 512 * (i); } else if ((i) < 13) { dil = 4; ks = base - 256 + 128 * ((i) - 5); } else { dil = 1; ks = base - 64 + 32 * ((i) - 13); } } while (0)
    bf16x8 kn[4], vn[4];
    { int dil, ks; BLK_INFO(0, dil, ks);
#pragma unroll
      for (int i = 0; i < 4; ++i) {
          int vp = ks + dil * (8 * i + (lane >> 3)); vp = vp < 0 ? 0 : (vp > SEQ - 1 ? SEQ - 1 : vp);
          kn[i] = *(const bf16x8*)(Kb + (size_t)vp * 512); vn[i] = *(const bf16x8*)(Vb + (size_t)vp * 512); } }
    for (int bi = 0; bi < 33; ++bi) {
        int dil, ks; BLK_INFO(bi, dil, ks);
        bf16x8 kf[4];
#pragma unroll
        for (int i = 0; i < 4; ++i) { *(LAS bf16x8*)(vst + (kw_off ^ ((i & 1) << 6)) + i * 1024) = kn[i]; *(LAS bf16x8*)(vst + vw_off + i * 1024) = vn[i]; }
#pragma unroll
        for (int ds = 0; ds < 4; ++ds) kf[ds] = *(const LAS bf16x8*)(vst + kr_base + (((2 * ds + h) ^ kr_sw) << 4));
        if (bi + 1 < 33) {
            int dil2, ks2; BLK_INFO(bi + 1, dil2, ks2);
#pragma unroll
            for (int i = 0; i < 4; ++i) {
                int vp = ks2 + dil2 * (8 * i + (lane >> 3)); vp = vp < 0 ? 0 : (vp > SEQ - 1 ? SEQ - 1 : vp);
                kn[i] = *(const bf16x8*)(Kb + (size_t)vp * 512); vn[i] = *(const bf16x8*)(Vb + (size_t)vp * 512); }
        }
        f32x16 s;
#pragma unroll
        for (int rr = 0; rr < 16; ++rr) s[rr] = 0.f;
#pragma unroll
        for (int ds = 0; ds < 4; ++ds) s = __builtin_amdgcn_mfma_f32_32x32x16_bf16(kf[ds], qf[ds], s, 0, 0, 0);
        const int lim = 64 * dil;
        const int lo = (-lim > -qp) ? -lim : -qp, hi_ = (lim < SEQ - 1 - qp) ? lim : SEQ - 1 - qp;
        const int e1 = ks + dil * 4 * h - qp - lo; const unsigned span = (unsigned)(hi_ - lo);
#pragma unroll
        for (int rr = 0; rr < 16; ++rr) {
            const unsigned x = (unsigned)(e1 + dil * ((rr & 3) + 8 * (rr >> 2)));
            s[rr] = (x <= span) ? s[rr] : -1e30f;
        }
        bf16x8 pf[2];
        softmax_block(s, m, l, o, bi == 0, pf);
#pragma unroll
        for (int s2 = 0; s2 < 2; ++s2)
#pragma unroll
            for (int db = 0; db < 2; ++db) {
                const LAS char* tp = (db == 0 ? tr0 : tr1) + s2 * 2048;
                const s16x4 lo = vtr(tp), hi = vtr(tp + 1024);
                const bf16x8 vf = (bf16x8){lo[0], lo[1], lo[2], lo[3], hi[0], hi[1], hi[2], hi[3]};
                o[db] = __builtin_amdgcn_mfma_f32_32x32x16_bf16(vf, pf[s2], o[db], 0, 0, 0);
            }
    }
#undef BLK_INFO
    const size_t row = (size_t)(b * SEQ + qp);
    attn_store(o, l, Y + row * 1024 + 512 + head * 64, ssb + row * 8 + head, h);
}


constexpr int BST_OFF = 65536, BST_M = BST_OFF + 65536, BST_L = BST_M + 2048, BST_END = BST_L + 4096;
__device__ __forceinline__ void attn_b_task(const bf16_t* QB, const bf16_t* KB, const bf16_t* VB, bf16_t* Y, float* ssb, int b, int head, int c, int pat, int j, LAS char* vst, LAS char* lds0, int lane) {
    const int q = lane & 31, h = lane >> 5;
    const int dil = (pat == 0) ? 16 : ((pat == 1) ? 4 : 1);
    const int qoff0 = (pat == 0) ? j : ((pat == 1) ? ((j & 3) + 128 * (j >> 2)) : 32 * j);
    const int qidx = qoff0 + dil * q, qp = 512 * c + qidx;
    bf16x8 qf[4];
#pragma unroll
    for (int ds = 0; ds < 4; ++ds) qf[ds] = *(const bf16x8*)(QB + (size_t)(b * SEQ + qp) * 512 + head * 64 + 16 * ds + 8 * h);
    const bf16_t* Kb = KB + (size_t)(b * SEQ) * 512 + head * 64 + (lane & 7) * 8;
    const bf16_t* Vb = VB + (size_t)(b * SEQ) * 512 + head * 64 + (lane & 7) * 8;
    const int ks0 = 512 * c + qoff0 - 64 * dil;
    bf16x8 kn[4], vn[4];
#pragma unroll
    for (int i = 0; i < 4; ++i) {
        int vp = ks0 + dil * (8 * i + (lane >> 3)); vp = vp < 0 ? 0 : (vp > SEQ - 1 ? SEQ - 1 : vp);
        kn[i] = *(const bf16x8*)(Kb + (size_t)vp * 512); vn[i] = *(const bf16x8*)(Vb + (size_t)vp * 512); }
    f32x16 o[2]; float m = 0.f, l = 0.f;
    const int swz = (qidx ^ (qidx >> 4)) & 15;
    LAS char* orow = lds0 + BST_OFF + qidx * 128;
    LAS float* mst = (LAS float*)(lds0 + BST_M); LAS float* lst = (LAS float*)(lds0 + BST_L);
    if (pat == 0) {
#pragma unroll
        for (int rr = 0; rr < 16; ++rr) { o[0][rr] = 0.f; o[1][rr] = 0.f; }
    } else {
#pragma unroll
        for (int db = 0; db < 2; ++db)
#pragma unroll
            for (int g = 0; g < 4; ++g) { const u32x2 w = *(const LAS u32x2*)(orow + (((8 * db + 2 * g + h) ^ swz) << 3));
                o[db][4 * g] = __uint_as_float(w.x << 16); o[db][4 * g + 1] = __uint_as_float(w.x & 0xffff0000u); o[db][4 * g + 2] = __uint_as_float(w.y << 16); o[db][4 * g + 3] = __uint_as_float(w.y & 0xffff0000u); }
        m = mst[qidx]; l = lst[h * 512 + qidx];
    }
    const int vw_off = (lane >> 3) * 128 + (((lane & 7) * 16) ^ (((lane >> 4) & 1) << 6));
    const int kw_off = 4096 + (lane >> 3) * 128 + (((lane & 7) ^ ((lane >> 4) & 7)) << 4);
    const int kr_base = 4096 + q * 128, kr_sw = (q >> 1) & 7;
    const int sw = (lane >> 3) & 1;
    const int trb = (4 * h + ((lane & 15) >> 2)) * 128 + 32 * ((lane >> 4) & 1) + 8 * (lane & 3);
    const LAS char* tr0 = vst + trb + 64 * sw;
    const LAS char* tr1 = vst + trb + 64 * (1 - sw);
    const int lim = 64 * dil;
    const int lo = (-lim > -qp) ? -lim : -qp, hi_ = (lim < SEQ - 1 - qp) ? lim : SEQ - 1 - qp;
    const unsigned span = (unsigned)(hi_ - lo);
#pragma unroll 1
    for (int kb = 0; kb < 5; ++kb) {
        const int ks = ks0 + 32 * dil * kb;
        bf16x8 kf[4];
#pragma unroll
        for (int i = 0; i < 4; ++i) { *(LAS bf16x8*)(vst + (kw_off ^ ((i & 1) << 6)) + i * 1024) = kn[i]; *(LAS bf16x8*)(vst + vw_off + i * 1024) = vn[i]; }
#pragma unroll
        for (int ds = 0; ds < 4; ++ds) kf[ds] = *(const LAS bf16x8*)(vst + kr_base + (((2 * ds + h) ^ kr_sw) << 4));
        if (kb + 1 < 5) {
            const int ks2 = ks + 32 * dil;
#pragma unroll
            for (int i = 0; i < 4; ++i) {
                int vp = ks2 + dil * (8 * i + (lane >> 3)); vp = vp < 0 ? 0 : (vp > SEQ - 1 ? SEQ - 1 : vp);
                kn[i] = *(const bf16x8*)(Kb + (size_t)vp * 512); vn[i] = *(const bf16x8*)(Vb + (size_t)vp * 512); }
        }
        f32x16 s;
#pragma unroll
        for (int rr = 0; rr < 16; ++rr) s[rr] = 0.f;
#pragma unroll
        for (int ds = 0; ds < 4; ++ds) s = __builtin_amdgcn_mfma_f32_32x32x16_bf16(kf[ds], qf[ds], s, 0, 0, 0);
        const int e1 = ks + dil * 4 * h - qp - lo;
#pragma unroll
        for (int rr = 0; rr < 16; ++rr) {
            const unsigned x = (unsigned)(e1 + dil * ((rr & 3) + 8 * (rr >> 2)));
            s[rr] = (x <= span) ? s[rr] : -1e30f;
        }
        bf16x8 pf[2];
        softmax_block(s, m, l, o, pat == 0 && kb == 0, pf);
#pragma unroll
        for (int s2 = 0; s2 < 2; ++s2)
#pragma unroll
            for (int db = 0; db < 2; ++db) {
                const LAS char* tp = (db == 0 ? tr0 : tr1) + s2 * 2048;
                const s16x4 lo4 = vtr(tp), hi4 = vtr(tp + 1024);
                const bf16x8 vf = (bf16x8){lo4[0], lo4[1], lo4[2], lo4[3], hi4[0], hi4[1], hi4[2], hi4[3]};
                o[db] = __builtin_amdgcn_mfma_f32_32x32x16_bf16(vf, pf[s2], o[db], 0, 0, 0);
            }
    }
    if (pat < 2) {
#pragma unroll
        for (int db = 0; db < 2; ++db)
#pragma unroll
            for (int g = 0; g < 4; ++g) { u32x2 w; w.x = cvtpk(o[db][4 * g], o[db][4 * g + 1]); w.y = cvtpk(o[db][4 * g + 2], o[db][4 * g + 3]);
                *(LAS u32x2*)(orow + (((8 * db + 2 * g + h) ^ swz) << 3)) = w; }
        if (h == 0) mst[qidx] = m;
        lst[h * 512 + qidx] = l;
    } else {
        const size_t row = (size_t)(b * SEQ + qp);
        attn_store(o, l, Y + row * 1024 + 512 + head * 64, ssb + row * 8 + head, h);
    }
}


__device__ __forceinline__ void attn_b_pair(const bf16_t* QB, const bf16_t* KB, const bf16_t* VB, bf16_t* Y, float* ssb, int b, int head, int c, int pat, int qoff0, LAS char* vst, LAS char* lds0, int lane) {
    const int q = lane & 31, h = lane >> 5;
    const int dil = (pat == 1) ? 4 : 1;
    int qidx[2], qp[2]; bf16x8 qf[2][4];
#pragma unroll
    for (int e = 0; e < 2; ++e) { qidx[e] = qoff0 + dil * (32 * e + q); qp[e] = 512 * c + qidx[e];
#pragma unroll
        for (int ds = 0; ds < 4; ++ds) qf[e][ds] = *(const bf16x8*)((const char*)(QB + (size_t)(b * SEQ) * 512 + head * 64) + ((unsigned)qp[e] * 1024u + (unsigned)h * 16u + ds * 32)); }
    const char* Kb = (const char*)(KB + (size_t)(b * SEQ) * 512 + head * 64);
    const char* Vb = (const char*)(VB + (size_t)(b * SEQ) * 512 + head * 64);
    const unsigned lo16 = (unsigned)(lane & 7) * 16u;
    const int ks0 = 512 * c + qoff0 - 64 * dil;
    bf16x8 kn[4], vn[4];
#pragma unroll
    for (int i = 0; i < 4; ++i) {
        int vp = ks0 + dil * (8 * i + (lane >> 3)); vp = vp < 0 ? 0 : (vp > SEQ - 1 ? SEQ - 1 : vp);
        const unsigned ko = (unsigned)vp * 1024u + lo16;
        kn[i] = *(const bf16x8*)(Kb + ko); vn[i] = *(const bf16x8*)(Vb + ko); }
    f32x16 o[2][2]; float m[2], l[2]; int lo[2]; unsigned span[2];
    LAS float* mst = (LAS float*)(lds0 + BST_M); LAS float* lst = (LAS float*)(lds0 + BST_L);
#pragma unroll
    for (int e = 0; e < 2; ++e) {
        const int swz = (qidx[e] ^ (qidx[e] >> 4)) & 15; const LAS char* orow = lds0 + BST_OFF + qidx[e] * 128;
#pragma unroll
        for (int db = 0; db < 2; ++db)
#pragma unroll
            for (int g = 0; g < 4; ++g) { const u32x2 w = *(const LAS u32x2*)(orow + (((8 * db + 2 * g + h) ^ swz) << 3));
                o[e][db][4 * g] = __uint_as_float(w.x << 16); o[e][db][4 * g + 1] = __uint_as_float(w.x & 0xffff0000u); o[e][db][4 * g + 2] = __uint_as_float(w.y << 16); o[e][db][4 * g + 3] = __uint_as_float(w.y & 0xffff0000u); }
        m[e] = mst[qidx[e]]; l[e] = lst[h * 512 + qidx[e]];
        const int lim = 64 * dil; lo[e] = (-lim > -qp[e]) ? -lim : -qp[e]; const int hi_ = (lim < SEQ - 1 - qp[e]) ? lim : SEQ - 1 - qp[e]; span[e] = (unsigned)(hi_ - lo[e]);
    }
    const int vw_off = (lane >> 3) * 128 + (((lane & 7) * 16) ^ (((lane >> 4) & 1) << 6));
    const int kw_off = 4096 + (lane >> 3) * 128 + (((lane & 7) ^ ((lane >> 4) & 7)) << 4);
    const int kr_base = 4096 + q * 128, kr_sw = (q >> 1) & 7;
    const int sw = (lane >> 3) & 1;
    const int trb = (4 * h + ((lane & 15) >> 2)) * 128 + 32 * ((lane >> 4) & 1) + 8 * (lane & 3);
    const LAS char* tr0 = vst + trb + 64 * sw;
    const LAS char* tr1 = vst + trb + 64 * (1 - sw);
#pragma unroll 1
    for (int t6 = 0; t6 < 6; ++t6) {
        const int ks = ks0 + 32 * dil * t6;
        bf16x8 kf[4];
#pragma unroll
        for (int i = 0; i < 4; ++i) { *(LAS bf16x8*)(vst + (kw_off ^ ((i & 1) << 6)) + i * 1024) = kn[i]; *(LAS bf16x8*)(vst + vw_off + i * 1024) = vn[i]; }
#pragma unroll
        for (int ds = 0; ds < 4; ++ds) kf[ds] = *(const LAS bf16x8*)(vst + kr_base + (((2 * ds + h) ^ kr_sw) << 4));
        if (t6 + 1 < 6) {
            const int ks2 = ks + 32 * dil;
#pragma unroll
            for (int i = 0; i < 4; ++i) {
                int vp = ks2 + dil * (8 * i + (lane >> 3)); vp = vp < 0 ? 0 : (vp > SEQ - 1 ? SEQ - 1 : vp);
                const unsigned ko = (unsigned)vp * 1024u + lo16;
                kn[i] = *(const bf16x8*)(Kb + ko); vn[i] = *(const bf16x8*)(Vb + ko); }
        }
        bf16x8 vf[2][2];
#pragma unroll
        for (int s2 = 0; s2 < 2; ++s2)
#pragma unroll
            for (int db = 0; db < 2; ++db) {
                const LAS char* tp = (db == 0 ? tr0 : tr1) + s2 * 2048;
                const s16x4 lo4 = vtr(tp), hi4 = vtr(tp + 1024);
                vf[s2][db] = (bf16x8){lo4[0], lo4[1], lo4[2], lo4[3], hi4[0], hi4[1], hi4[2], hi4[3]};
            }
#pragma unroll
        for (int e = 0; e < 2; ++e) {
            if ((e == 0 && t6 == 5) || (e == 1 && t6 == 0)) continue;
            f32x16 s;
#pragma unroll
            for (int rr = 0; rr < 16; ++rr) s[rr] = 0.f;
#pragma unroll
            for (int ds = 0; ds < 4; ++ds) s = __builtin_amdgcn_mfma_f32_32x32x16_bf16(kf[ds], qf[e][ds], s, 0, 0, 0);
            const int e1 = ks + dil * 4 * h - qp[e] - lo[e];
#pragma unroll
            for (int rr = 0; rr < 16; ++rr) {
                const unsigned x = (unsigned)(e1 + dil * ((rr & 3) + 8 * (rr >> 2)));
                s[rr] = (x <= span[e]) ? s[rr] : -1e30f;
            }
            bf16x8 pf[2];
            softmax_block(s, m[e], l[e], o[e], false, pf);
#pragma unroll
            for (int s2 = 0; s2 < 2; ++s2)
#pragma unroll
                for (int db = 0; db < 2; ++db) o[e][db] = __builtin_amdgcn_mfma_f32_32x32x16_bf16(vf[s2][db], pf[s2], o[e][db], 0, 0, 0);
        }
    }
#pragma unroll
    for (int e = 0; e < 2; ++e) {
        if (pat < 2) {
            const int swz = (qidx[e] ^ (qidx[e] >> 4)) & 15; LAS char* orow = lds0 + BST_OFF + qidx[e] * 128;
#pragma unroll
            for (int db = 0; db < 2; ++db)
#pragma unroll
                for (int g = 0; g < 4; ++g) { u32x2 w; w.x = cvtpk(o[e][db][4 * g], o[e][db][4 * g + 1]); w.y = cvtpk(o[e][db][4 * g + 2], o[e][db][4 * g + 3]);
                    *(LAS u32x2*)(orow + (((8 * db + 2 * g + h) ^ swz) << 3)) = w; }
            if (h == 0) mst[qidx[e]] = m[e];
            lst[h * 512 + qidx[e]] = l[e];
        } else {
            const size_t row = (size_t)(b * SEQ + qp[e]);
            attn_store(o[e], l[e], Y + row * 1024 + 512 + head * 64, ssb + row * 8 + head, h);
        }
    }
}

constexpr int I_IN = 16 * 72, I_OUT = 16 * 32, I_1 = 16 * 128, I_2 = 64 * 32, I_L = I_IN + I_OUT + I_1 + I_2;
__device__ __forceinline__ void convert_layer(const Params& p, int L, int it0, int nstep, LAS float* scr, int lane, int ibeg, int iend) {
    bf16_t* wl = (bf16_t*)(p.ws + WS_W + (size_t)L * W_LAYER);
    for (int it = ibeg + it0; it < iend; it += nstep) {
        int r = it;
        if (r < I_IN) { const int kb = r / 72, nb = r % 72, n0 = 32 * nb, k0 = 64 * kb;
            const int ot = n0 >> 8, pos = (ot == 7) ? 0 : ((ot == 8) ? 4 : ((ot <= 2) ? ot + 1 : ot + 2));
            const int d0 = pos * 256 + ((n0 >> 5) & 1) * 128 + ((n0 >> 6) & 3) * 32;
            transpose_item(p.w_in + (size_t)L * DM * INW, DM, INW, wl, k0, n0, d0, p.norm1 + L * DM + k0, scr, lane); continue; }
        r -= I_IN;
        if (r < I_OUT) { const int kb = r / 32, nb = r % 32, n0 = 32 * nb, k0 = 64 * kb;
            const float* g0 = (k0 < 512) ? p.out_norm_a + L * 512 + k0 : p.out_norm_b + L * 512 + (k0 - 512);
            transpose_item(p.w_out + (size_t)L * DM * DM, DM, DM, wl + 2359296, k0, n0, n0, g0, scr, lane); continue; }
        r -= I_OUT;
        if (r < I_1) { const int kb = r / 128, nb = r % 128, n0 = 32 * nb, k0 = 64 * kb;
            transpose_item(p.w_mlp_in + (size_t)L * DM * FF, DM, FF, wl + 2359296 + 1048576, k0, n0, n0, p.norm2 + L * DM + k0, scr, lane); continue; }
        r -= I_1;
        { const int kb = r / 32, nb = r % 32, n0 = 32 * nb, k0 = 64 * kb;
            transpose_item(p.w_mlp_out + (size_t)L * FF * DM, FF, DM, wl + 2359296 + 1048576 + 4194304, k0, n0, n0, nullptr, scr, lane); }
    }
}

#define XB_TMO      128
#define XB_XCNT(j)  (256  + 64 * (j))
#define XB_XSUB(j)  (1280 + 64 * (j))
#define XB_XGEN(j)  (2304 + 64 * (j))
#define XB_TOP      3328
#define XB_TOPGEN   3392
#define XCD_BAR_WORDS 3456
#define XB_SPIN_CAP (1u << 18)

__device__ __forceinline__ unsigned xb_ld(unsigned* p)              { return __hip_atomic_load(p, __ATOMIC_RELAXED, __HIP_MEMORY_SCOPE_AGENT); }
__device__ __forceinline__ unsigned xb_add(unsigned* p, unsigned v) { return __hip_atomic_fetch_add(p, v, __ATOMIC_RELAXED, __HIP_MEMORY_SCOPE_AGENT); }
__device__ __forceinline__ unsigned xb_xcc_id() { return (unsigned)__builtin_amdgcn_s_getreg((3 << 11) | 20) & 0xFu; }
#define XB_SPIN(cond, bar) do { unsigned _sp = 0; while (cond) { __builtin_amdgcn_s_sleep(1); \
    if ((++_sp & 255u) == 0u) { if (xb_ld(&(bar)[XB_TMO])) break; if (_sp > XB_SPIN_CAP) { atomicAdd(&(bar)[XB_TMO], 1u); break; } } } } while (0)

struct XcdBarrier {
    unsigned* bar; unsigned x;
    volatile LAS unsigned* st;
};

__device__ __forceinline__ XcdBarrier xcd_barrier_post(unsigned* bar, volatile LAS unsigned* st) {
    XcdBarrier b; b.bar = bar; b.x = xb_xcc_id(); b.st = st;
    if (threadIdx.x == 0) (void)xb_add(&bar[XB_XCNT(b.x)], 1u);
    return b;
}
__device__ __forceinline__ void xcd_barrier_complete(unsigned* bar, unsigned x, unsigned& nloc, unsigned& nx) {
    const unsigned G = gridDim.x * gridDim.y * gridDim.z;
    unsigned sum, cnt, mine, sp = 0u;
    for (;;) {
        sum = 0u; cnt = 0u; mine = 0u;
        unsigned cv[16];
#pragma unroll
        for (unsigned j = 0; j < 16; ++j) cv[j] = xb_ld(&bar[XB_XCNT(j)]);
#pragma unroll
        for (unsigned j = 0; j < 16; ++j) { const unsigned c = cv[j]; sum += c; cnt += (c > 0u) ? 1u : 0u; mine = (j == x) ? c : mine; }
        if (sum == G) break;
        __builtin_amdgcn_s_sleep(1);
        if ((++sp & 255u) == 0u) { if (xb_ld(&bar[XB_TMO])) break; if (sp > XB_SPIN_CAP) { atomicAdd(&bar[XB_TMO], 1u); break; } }
    }
    nloc = mine > 0u ? mine : 1u; nx = cnt > 0u ? cnt : 1u;
}

__device__ __forceinline__ void xcd_barrier(const XcdBarrier& b) {
    asm volatile("s_waitcnt vmcnt(0)" ::: "memory");
    __syncthreads();
    if (threadIdx.x == 0) {
        unsigned* bar = b.bar; unsigned bxcc = b.x; asm volatile("" : "+s"(bxcc));
        __builtin_amdgcn_s_waitcnt(0);
        unsigned nloc = b.st[0], nx = b.st[1];
        if (nloc == 0u) { xcd_barrier_complete(bar, bxcc, nloc, nx); b.st[0] = nloc; b.st[1] = nx; }
        const unsigned old = xb_add(&bar[XB_XSUB(bxcc)], 1u);
        const unsigned gen = old / nloc;
        if (old + 1u == (gen + 1u) * nloc) {
            __builtin_amdgcn_fence(__ATOMIC_RELEASE, "agent");
            asm volatile("s_waitcnt vmcnt(0)" ::: "memory");
            const unsigned og = xb_add(&bar[XB_TOP], 1u);
            const unsigned tg = og / nx;
            if (og + 1u == (tg + 1u) * nx) xb_add(&bar[XB_TOPGEN], 1u);
            else XB_SPIN(xb_ld(&bar[XB_TOPGEN]) == tg, bar);
            __builtin_amdgcn_fence(__ATOMIC_ACQUIRE, "agent");
            xb_add(&bar[XB_XGEN(bxcc)], 1u);
            asm volatile("s_waitcnt vmcnt(0)" ::: "memory");
        } else {
            XB_SPIN(xb_ld(&bar[XB_XGEN(bxcc)]) == gen, bar);
            __builtin_amdgcn_fence(__ATOMIC_ACQUIRE, "agent");
            asm volatile("s_waitcnt vmcnt(0)" ::: "memory");
        }
    }
    __syncthreads();
}

#define CG_SYNC() do { asm volatile("s_waitcnt vmcnt(0) lgkmcnt(0)" ::: "memory"); grid.sync(); __builtin_amdgcn_fence(__ATOMIC_ACQUIRE, "agent"); asm volatile("s_waitcnt vmcnt(0)" ::: "memory"); } while (0)
#define GRID_SYNC() xcd_barrier(xbar)
constexpr int ATT_NQ = 2;
#ifdef TS_SEL
#define TS_INIT() float* TS = (float*)(p.ws + 600000); unsigned long long tprev = 0; if (blockIdx.x == 0 && threadIdx.x == 0) { for (int i = 0; i < 16; ++i) TS[i] = 0.f; tprev = __builtin_amdgcn_s_memrealtime(); }
#define STAMP(slot) do { if (blockIdx.x == 0 && threadIdx.x == 0) { asm volatile("s_waitcnt vmcnt(0) lgkmcnt(0)" ::: "memory"); const unsigned long long now_ = __builtin_amdgcn_s_memrealtime(); TS[slot] += (float)(now_ - tprev); tprev = now_; } } while (0)
#define TS_FINISH() do { if (blockIdx.x == 0 && threadIdx.x == 0) p.out[0] = TS[TS_SEL] * 0.01f; } while (0)
#else
#define TS_INIT() do {} while (0)
#define STAMP(slot) do {} while (0)
#define TS_FINISH() do {} while (0)
#endif
__global__ void __launch_bounds__(512) fwd_megakernel(Params p) {
    extern __shared__ __attribute__((aligned(16))) unsigned char lds_raw[];
    LAS unsigned char* lds = (LAS unsigned char*)lds_raw;
    cg::grid_group grid = cg::this_grid();
    const int tid = threadIdx.x, lane = tid & 63, wave = __builtin_amdgcn_readfirstlane(tid >> 6);
    const int G = gridDim.x, bx = blockIdx.x;
    const int gw = bx * 8 + wave, NGW = G * 8;
    unsigned char* ws = p.ws;
    float* cosA = (float*)(ws + WS_COSA); float* sinA = (float*)(ws + WS_SINA); float* cosB = (float*)(ws + WS_COSB); float* sinB = (float*)(ws + WS_SINB);
    float* SSP = (float*)(ws + WS_SS); float* SSA = SSP + (size_t)M * 16; float* SSB = SSA + (size_t)M * 8;
    bf16_t* XB = (bf16_t*)(ws + WS_XB);
    bf16_t* HB = (bf16_t*)(ws + WS_H);
    bf16_t *QA = (bf16_t*)(ws + WS_QA), *KA = (bf16_t*)(ws + WS_KA), *VA = (bf16_t*)(ws + WS_VA), *QB = (bf16_t*)(ws + WS_QB), *KB = (bf16_t*)(ws + WS_KB), *VB = (bf16_t*)(ws + WS_VB), *Y = (bf16_t*)(ws + WS_Y);

    TS_INIT();
    volatile LAS unsigned* xst = (volatile LAS unsigned*)(lds + 139264 - 64);
    if (tid < 2) xst[tid] = 0u;
    if (bx == 0) for (int i = tid; i < (int)(BAR_BYTES / 4); i += 512) __hip_atomic_store((unsigned*)(ws + WS_BAR) + i, 0u, __ATOMIC_RELAXED, __HIP_MEMORY_SCOPE_AGENT);
    CG_SYNC();
    XcdBarrier xbar = xcd_barrier_post((unsigned*)(ws + WS_BAR), xst);
    {
        LAS float* scr = (LAS float*)(lds + wave * 16384);
        { const int n3 = 576 - 2 * G; const bool hide = (n3 > 0 && n3 < G);
          if (hide) convert_layer(p, 0, gw, NGW, scr, lane, 0, I_IN);
          else for (int L0 = 0; L0 < DEPTH; ++L0) convert_layer(p, L0, gw, NGW, scr, lane, 0, I_L); }
        for (int mrow = gw; mrow < M; mrow += NGW) {
            const f32x4* xr = (const f32x4*)(p.x + (size_t)mrow * DM) + lane; float s = 0.f;
            unsigned long long* o8 = (unsigned long long*)(XB + (size_t)mrow * DM) + lane;
#pragma unroll
            for (int j = 0; j < 4; ++j) { const f32x4 v = __builtin_nontemporal_load(xr + 64 * j); s += (v[0] * v[0] + v[1] * v[1]) + (v[2] * v[2] + v[3] * v[3]);
                o8[64 * j] = (unsigned long long)pk2(v[0], v[1]) | ((unsigned long long)pk2(v[2], v[3]) << 32); }
            s = wave_sum(s);
            if (lane < 16) SSP[(size_t)mrow * 16 + lane] = (lane == 0) ? s : 0.f;
        }
        for (int i = bx * 512 + tid; i < 64 * 16 + 4096 * 8; i += G * 512) {
            int fi, pos; if (i < 1024) { fi = i & 15; pos = i >> 4; } else { fi = 16 + ((i - 1024) & 7); pos = (i - 1024) >> 3; }
            double f = 0.0;
#pragma unroll
            for (int k = 0; k < 24; ++k) if (fi == k) f = p.frev[k];
            double rev = (double)pos * f; rev -= floor(rev);
            const float fr = (float)rev;
            const float sv = __builtin_amdgcn_sinf(fr), cv = __builtin_amdgcn_cosf(fr);
            if (i < 1024) { cosA[i] = cv; sinA[i] = sv; } else { cosB[i - 1024] = cv; sinB[i - 1024] = sv; }
        }
    }
    STAMP(0); GRID_SYNC(); STAMP(7);

    for (int L = 0; L < DEPTH; ++L) {
        const bf16_t* wl = (const bf16_t*)(ws + WS_W + (size_t)L * W_LAYER);
        const bf16_t* Win = wl; const bf16_t* Wout = wl + 2359296; const bf16_t* W1 = Wout + 1048576; const bf16_t* W2 = W1 + 4194304;
        float* ss1 = SSP; float* ss2 = SSP; float* ssn = SSP; float* ssa = SSA; float* ssb = SSB;
        {
            pg8::Gemm g{XB, Win, M, INW, DM}; pg8::StaticOrder S; S.init(M, INW, G, bx);
            pg8::EpiInProj E{ss1, p.q_norm + L * 64, p.k_norm + L * 64, cosA, sinA, cosB, sinB, QA, KA, VA, QB, KB, VB};
            pg8::gemm_phase<pg8::EpiInProj, pg8::StaticOrder, true, true>(lds, g, S, E);
            const int n3 = 576 - 2 * G;
            if (L == 0 && n3 > 0 && n3 < G && bx >= n3) { int lane_d = lane; asm volatile("" : "+v"(lane_d));
                convert_layer(p, 0, (bx - n3) * 8 + wave, (G - n3) * 8, (LAS float*)(lds + wave * 16384), lane_d, I_IN, I_L); }
            if (L + 1 < DEPTH && n3 > 0 && n3 < G && bx >= n3) { int lane_c = lane; asm volatile("" : "+v"(lane_c));
                convert_layer(p, L + 1, (bx - n3) * 8 + wave, (G - n3) * 8, (LAS float*)(lds + wave * 16384), lane_c, 0, I_L); }
        }
        STAMP(1); GRID_SYNC(); STAMP(7);
        {
            int lane_ = lane; asm volatile("" : "+v"(lane_));
            const int lane = lane_;
            LAS char* vst = (LAS char*)(lds + wave * 8192);
            const int vb = (bx & 7) * (G >> 3) + (bx >> 3);
            for (int u0 = vb; u0 < 256; u0 += G)
#pragma unroll 1
                for (int i = 0; i < 2; ++i) { const int u = 2 * u0 + i;
                    attn_body::attn_unit<8>(u >> 7, (u & 63) >> 3, 8 * ((u >> 6) & 1) + (u & 7), (const attn_body::bf16*)QA, (const attn_body::bf16*)KA, (const attn_body::bf16*)VA, (attn_body::bf16*)Y, ssa, (char*)lds_raw); }
            STAMP(2);
            for (int grp = vb; grp < BATCH * 8 * 8; grp += G) {
                const int b = grp >> 6, head = (grp & 31) >> 2, c = 4 * ((grp >> 5) & 1) + (grp & 3);
                int lane_b = lane; asm volatile("" : "+v"(lane_b));
                const int lane = lane_b;
#pragma unroll 1
                for (int jj = 0; jj < 2; ++jj) attn_b_task(QB, KB, VB, Y, ssb, b, head, c, 0, wave + 8 * jj, vst, (LAS char*)lds, lane);
                asm volatile("s_waitcnt lgkmcnt(0)" ::: "memory"); __syncthreads();
#pragma unroll 1
                for (int pat = 1; pat < 3; ++pat) {
                    const int qoff0 = (pat == 1) ? ((wave & 3) + 256 * (wave >> 2)) : 64 * wave;
                    attn_b_pair(QB, KB, VB, Y, ssb, b, head, c, pat, qoff0, vst, (LAS char*)lds, lane);
                    asm volatile("s_waitcnt lgkmcnt(0)" ::: "memory"); __syncthreads();
                }
            }
        }
        STAMP(3); GRID_SYNC(); STAMP(7);
        {
            pg8::Gemm g{Y, Wout, M, DM, DM}; pg8::StaticOrder S; S.init(M, DM, G, bx);
            pg8::EpiRes<true> E{XB, ss2, ssa, ssb};
            pg8::gemm_phase<pg8::EpiRes<true>, pg8::StaticOrder, true, true>(lds, g, S, E);
        }
        STAMP(4); GRID_SYNC(); STAMP(7);
        {
            pg8::Gemm g{XB, W1, M, FF, DM}; pg8::StaticOrder S; S.init(M, FF, G, bx);
            pg8::EpiMlpIn E{ss2, HB};
            pg8::gemm_phase<pg8::EpiMlpIn, pg8::StaticOrder, true, true>(lds, g, S, E);
        }
        STAMP(5); GRID_SYNC(); STAMP(7);
        {
            pg8::Gemm g{HB, W2, M, DM, FF}; pg8::StaticOrder S; S.init(M, DM, G, bx);
            pg8::EpiRes<false> E{XB, ssn, nullptr, nullptr};
            pg8::gemm_phase<pg8::EpiRes<false>, pg8::StaticOrder, true, true>(lds, g, S, E);
        }
        STAMP(6); GRID_SYNC(); STAMP(7);
    }
    {
        int lane_f = lane; asm volatile("" : "+v"(lane_f));
        const int lane = lane_f;
        int tid_f = threadIdx.x; asm volatile("" : "+v"(tid_f));
        const int gw_f = (int)blockIdx.x * 8 + __builtin_amdgcn_readfirstlane(tid_f >> 6);
        const float* ssf = SSP;
        for (int mrow = gw_f; mrow < M; mrow += NGW) {
            const float rs = rsqrtf(pg8::sum16(ssf + (size_t)mrow * 16) * (1.0f / 1024.0f) + 1e-6f);
            f32x4* xr = (f32x4*)(p.out + (size_t)mrow * DM) + lane; const f32x4* gr = (const f32x4*)p.final_norm + lane;
            const u32x2* xbr = (const u32x2*)(XB + (size_t)mrow * DM) + lane;
#pragma unroll
            for (int j = 0; j < 4; ++j) { const u32x2 w = __builtin_nontemporal_load(xbr + 64 * j);
                const f32x4 v = (f32x4){__uint_as_float(w.x << 16), __uint_as_float(w.x & 0xffff0000u), __uint_as_float(w.y << 16), __uint_as_float(w.y & 0xffff0000u)};
                __builtin_nontemporal_store(v * rs * gr[64 * j], xr + 64 * j); }
        }
    }
    STAMP(8); TS_FINISH();
}

extern "C" void kernel_launch(void* const* d_in, const int* in_sizes, int n_in, void* d_out, int out_size, void* d_ws, size_t ws_size, hipStream_t stream) {
    static int grid_blocks = 0;
    if (grid_blocks == 0) {
        if (n_in != 12 || ws_size < WS_END) { fprintf(stderr, "kernel_launch: unexpected inputs (n_in %d, ws %zu)\n", n_in, ws_size); grid_blocks = -1; return; }
        int dev = 0, cus = 0, per_cu = 0;
        hipGetDevice(&dev);
        hipDeviceGetAttribute(&cus, hipDeviceAttributeMultiprocessorCount, dev);
        hipFuncSetAttribute((const void*)fwd_megakernel, hipFuncAttributeMaxDynamicSharedMemorySize, LDS_BYTES);
        hipOccupancyMaxActiveBlocksPerMultiprocessor(&per_cu, (const void*)fwd_megakernel, 512, LDS_BYTES);
        if (per_cu < 1) { fprintf(stderr, "kernel_launch: occupancy query says %d blocks per CU\n", per_cu); grid_blocks = -1; return; }
        grid_blocks = cus * per_cu;
        if (grid_blocks % 8 != 0) grid_blocks -= grid_blocks % 8;
    }
    if (grid_blocks < 0) return;
    Params p{};
    p.x = (const float*)d_in[0]; p.norm1 = (const float*)d_in[1]; p.w_in = (const float*)d_in[2]; p.q_norm = (const float*)d_in[3]; p.k_norm = (const float*)d_in[4];
    p.out_norm_a = (const float*)d_in[5]; p.out_norm_b = (const float*)d_in[6]; p.w_out = (const float*)d_in[7]; p.norm2 = (const float*)d_in[8];
    p.w_mlp_in = (const float*)d_in[9]; p.w_mlp_out = (const float*)d_in[10]; p.final_norm = (const float*)d_in[11];
    p.out = (float*)d_out; p.ws = (unsigned char*)d_ws;
    const double two_pi = 6.283185307179586476925286766559;
    for (int i = 0; i < 16; ++i) p.frev[i] = pow(10000.0, -(double)i / 16.0) / two_pi;
    for (int i = 0; i < 8; ++i) p.frev[16 + i] = pow(500000.0, -(double)i / 8.0) / two_pi;
    void* args[] = {&p};
    hipError_t e = hipLaunchCooperativeKernel((const void*)fwd_megakernel, dim3(grid_blocks), dim3(512), args, LDS_BYTES, stream);
    if (e != hipSuccess) fprintf(stderr, "cooperative launch failed: %s (grid %d)\n", hipGetErrorString(e), grid_blocks);
}
```

```cpp
#include <hip/hip_runtime.h>
#include <hip/hip_cooperative_groups.h>
#include <cstdio>
#include <cstdint>
#include <cmath>
namespace cg = cooperative_groups;
namespace pg8 {
#define PG8_LAS __attribute__((address_space(3)))
typedef unsigned short bf16_t;
typedef short bf16x8 __attribute__((ext_vector_type(8)));
typedef float f32x4 __attribute__((ext_vector_type(4)));
typedef unsigned u32x4 __attribute__((ext_vector_type(4)));
constexpr int BM = 256, BK = 64, HALF = 128, HTB = HALF * BK * 2  , STAGE_BYTES = 8 * HTB, NXCD = 8, WGM = 8;

__host__ __device__ __forceinline__ int lds_byte(int r, int c) { const int st = (r >> 4) * 2 + (c >> 5), rr = r & 15, cc = c & 31, ob = rr * 64 + cc * 2; return st * 1024 + (ob ^ (((ob >> 9) & 1) << 5)); }
__host__ __device__ __forceinline__ void stage_rc(int b, int& R, int& C) { const int st = b / 1024, sb = b % 1024, swz = sb ^ (((sb >> 9) & 1) << 5); R = (st >> 1) * 16 + swz / 64; C = (st & 1) * 32 + (swz % 64) / 2; }
__host__ __device__ __forceinline__ int perm32(int rho) { const int n = rho >> 4, i = rho & 15; return 8 * (i >> 2) + 4 * n + (i & 3); }

struct Unit { int pm, pn; };
struct Gemm { const bf16_t* A; const bf16_t* Bt; int M, N, K; };

struct StaticOrder {
    int nM, nN, nwg, G, c;
    __host__ __device__ void init(int M, int N, int G_, int c_) { nM = M / BM; nN = N / BM; nwg = nM * nN; G = G_; c = c_; }
    __host__ __device__ bool next(int i, Unit& u) const {
        const long L = (long)i * G + c; if (L >= nwg) return false;
        int wgid = (int)L; { const int q = nwg / NXCD, r = nwg % NXCD, xcd = wgid % NXCD, off = wgid / NXCD; wgid = (xcd < r ? xcd * (q + 1) : r * (q + 1) + (xcd - r) * q) + off; }
        const int nig = WGM * nN, gid = wgid / nig, fm = gid * WGM, gsz = (nM - fm) < WGM ? (nM - fm) : WGM;
        u.pm = fm + ((wgid % nig) % gsz); u.pn = (wgid % nig) / gsz; return true;
    }
    __device__ __forceinline__ void a_ready(const Unit&) const {}
    __device__ __forceinline__ void done(const Unit&) const {}
};

__device__ __forceinline__ unsigned cvt_pk_bf16(float lo, float hi) { unsigned r; asm volatile("v_cvt_pk_bf16_f32 %0, %1, %2" : "=v"(r) : "v"(lo), "v"(hi)); return r; }
typedef unsigned u32x2 __attribute__((ext_vector_type(2)));
constexpr float NORM_EPS = 1e-6f;
__device__ __forceinline__ float sum16(const float* p) { const f32x4 a = *(const f32x4*)p, b = *(const f32x4*)(p + 4), c = *(const f32x4*)(p + 8), d = *(const f32x4*)(p + 12);
    return (((a[0] + a[1]) + (a[2] + a[3])) + ((b[0] + b[1]) + (b[2] + b[3]))) + (((c[0] + c[1]) + (c[2] + c[3])) + ((d[0] + d[1]) + (d[2] + d[3]))); }
__device__ __forceinline__ float sum8(const float* p) { const f32x4 a = *(const f32x4*)p, b = *(const f32x4*)(p + 4); return ((a[0] + a[1]) + (a[2] + a[3])) + ((b[0] + b[1]) + (b[2] + b[3])); }
template <int NP> __device__ __forceinline__ void rows_rstd(const float* ss, int row0, int fq, float inv_n, float (&rs)[8]) {
    f32x4 v[8];
#pragma unroll
    for (int i = 0; i < 8; ++i) v[i] = *(const f32x4*)(ss + (size_t)(row0 + (i >> 2) * HALF + (i & 3) * 16) * NP + 4 * (fq & (NP / 4 - 1)));
#pragma unroll
    for (int i = 0; i < 8; ++i) { float q = (v[i][0] + v[i][1]) + (v[i][2] + v[i][3]); q += __shfl_xor(q, 16); if (NP == 16) q += __shfl_xor(q, 32); rs[i] = rsqrtf(q * inv_n + NORM_EPS); }
}
constexpr float QSCALE = 0.125f * 1.4426950408889634f;

struct EpiInProj {
    static constexpr bool PERM = false, AFTER_DRAIN = false, MID = false;
    const float* ss;
    const float* qg; const float* kg;
    const float* cosA; const float* sinA;
    const float* cosB; const float* sinB;
    bf16_t *QA, *KA, *VA, *QB, *KB, *VB;
    __device__ __forceinline__ void operator()(const f32x4 (&acc)[2][2][4][2], const Unit& u, int wr, int wc, int fr_, int fq_) const {
        int fr = fr_, fq = fq_; asm volatile("" : "+v"(fr), "+v"(fq));
        const int otile = (u.pn == 0) ? 7 : ((u.pn == 4) ? 8 : ((u.pn < 4) ? u.pn - 1 : u.pn - 2));
        const int hg = otile * 4 + wc;
        int type; bf16_t* dst; int pitch;
        if (hg < 8)       { type = 0; dst = QA + hg * 64;        pitch = 512; }
        else if (hg < 10) { type = 1; dst = KA + (hg - 8) * 64;  pitch = 128; }
        else if (hg < 12) { type = 2; dst = VA + (hg - 10) * 64; pitch = 128; }
        else if (hg < 20) { type = 3; dst = QB + (hg - 12) * 64; pitch = 512; }
        else if (hg < 28) { type = 4; dst = KB + (hg - 20) * 64; pitch = 512; }
        else              { type = 5; dst = VB + (hg - 28) * 64; pitch = 512; }
        const float* __restrict__ cosA_ = cosA; const float* __restrict__ sinA_ = sinA; const float* __restrict__ cosB_ = cosB; const float* __restrict__ sinB_ = sinB;
        bf16_t* __restrict__ dst_ = dst;
        f32x4 g4[2][2];
        if (type <= 1) { const float* g = (type == 0) ? qg : kg;
#pragma unroll
            for (int bj = 0; bj < 2; ++bj)
#pragma unroll
                for (int n = 0; n < 2; ++n) g4[bj][n] = *(const f32x4*)(g + 32 * bj + 16 * n + 4 * fq);
        }
        float rs8[8]; rows_rstd<16>(ss, u.pm * BM + wr * 64 + fr, fq, 1.0f / 1024.0f, rs8);
#pragma unroll
        for (int ai = 0; ai < 2; ++ai)
#pragma unroll
            for (int m = 0; m < 4; ++m) {
                const int row = u.pm * BM + ai * HALF + wr * 64 + m * 16 + fr;
                const int t = row & 4095;
                const float rs = rs8[ai * 4 + m];
                f32x4 v[2][2];
#pragma unroll
                for (int bj = 0; bj < 2; ++bj)
#pragma unroll
                    for (int n = 0; n < 2; ++n) v[bj][n] = acc[ai][bj][m][n] * rs;
                if (type <= 1) {
                    float q = 0.f;
#pragma unroll
                    for (int bj = 0; bj < 2; ++bj)
#pragma unroll
                        for (int n = 0; n < 2; ++n) { const f32x4 x = v[bj][n]; q += (x[0] * x[0] + x[1] * x[1]) + (x[2] * x[2] + x[3] * x[3]); }
                    q += __shfl_xor(q, 16); q += __shfl_xor(q, 32);
                    const float rn = rsqrtf(q * (1.0f / 64.0f) + NORM_EPS);
#pragma unroll
                    for (int bj = 0; bj < 2; ++bj) {
                        const int pos = (bj == 0) ? (t >> 6) : (t & 63);
                        const f32x4 c4 = *(const f32x4*)(cosA_ + pos * 16 + 4 * fq), s4 = *(const f32x4*)(sinA_ + pos * 16 + 4 * fq);
                        const f32x4 x1 = v[bj][0] * rn * g4[bj][0], x2 = v[bj][1] * rn * g4[bj][1];
                        v[bj][0] = x1 * c4 - x2 * s4; v[bj][1] = x2 * c4 + x1 * s4;
                    }
                } else if (type == 3 || type == 4) {
                    const f32x4 own = v[0][0]; f32x4 oth;
#pragma unroll
                    for (int j = 0; j < 4; ++j) oth[j] = __shfl_xor(own[j], 32);
                    const f32x4 c4 = *(const f32x4*)(cosB_ + t * 8 + 4 * (fq & 1)), s4 = *(const f32x4*)(sinB_ + t * 8 + 4 * (fq & 1));
                    const f32x4 os = oth * s4;
                    v[0][0] = own * c4 + ((fq < 2) ? -os : os);
                }
                if (type == 0 || type == 3) {
#pragma unroll
                    for (int bj = 0; bj < 2; ++bj)
#pragma unroll
                        for (int n = 0; n < 2; ++n) v[bj][n] = v[bj][n] * QSCALE;
                }
                bf16_t* rowp = dst_ + (size_t)row * pitch + 4 * fq;
#pragma unroll
                for (int bj = 0; bj < 2; ++bj)
#pragma unroll
                    for (int n = 0; n < 2; ++n) { u32x2 w; w.x = cvt_pk_bf16(v[bj][n][0], v[bj][n][1]); w.y = cvt_pk_bf16(v[bj][n][2], v[bj][n][3]);
                        *(u32x2*)(rowp + 32 * bj + 16 * n) = w; }
                asm volatile("" ::: "memory");
            }
    }
};

template <bool OUTPROJ> struct EpiRes {
    static constexpr bool PERM = false, AFTER_DRAIN = false, MID = OUTPROJ;
    bf16_t* xb; float* ssn; const float* ssa; const float* ssb;
    __device__ __forceinline__ void mid(f32x4 (&acc)[2][2][4][2], const Unit& u, int wr, int wc, int fr_, int fq_) const {
        int fr = fr_, fq = fq_; asm volatile("" : "+v"(fr), "+v"(fq));
        float ra[8], rb[8]; rows_rstd<8>(ssa, u.pm * BM + wr * 64 + fr, fq, 1.0f / 512.0f, ra); rows_rstd<8>(ssb, u.pm * BM + wr * 64 + fr, fq, 1.0f / 512.0f, rb);
#pragma unroll
        for (int ai = 0; ai < 2; ++ai)
#pragma unroll
            for (int m = 0; m < 4; ++m) {
                const float f = ra[ai * 4 + m] * __builtin_amdgcn_rcpf(rb[ai * 4 + m]);
#pragma unroll
                for (int bj = 0; bj < 2; ++bj)
#pragma unroll
                    for (int n = 0; n < 2; ++n) acc[ai][bj][m][n] = acc[ai][bj][m][n] * f;
            }
    }
    __device__ __forceinline__ void operator()(const f32x4 (&acc)[2][2][4][2], const Unit& u, int wr, int wc, int fr_, int fq_) const {
        int fr = fr_, fq = fq_; asm volatile("" : "+v"(fr), "+v"(fq));
        const int col0 = u.pn * BM + wc * 32 + 4 * fq, row0 = u.pm * BM + wr * 64 + fr;
        float sc8[8];
        if (OUTPROJ) rows_rstd<8>(ssb, row0, fq, 1.0f / 512.0f, sc8);
#pragma unroll
        for (int ai = 0; ai < 2; ++ai) {
            u32x2 wb[4][2][2];
#pragma unroll
            for (int m = 0; m < 4; ++m)
#pragma unroll
                for (int bj = 0; bj < 2; ++bj)
#pragma unroll
                    for (int n = 0; n < 2; ++n) wb[m][bj][n] = *(const u32x2*)(xb + (size_t)(row0 + ai * HALF + m * 16) * 1024 + col0 + bj * HALF + n * 16);
#pragma unroll
            for (int m = 0; m < 4; ++m) {
                const int row = row0 + ai * HALF + m * 16;
                const float sc = OUTPROJ ? sc8[ai * 4 + m] : 1.f;
                const size_t off = (size_t)row * 1024 + col0;
                float part = 0.f;
#pragma unroll
                for (int bj = 0; bj < 2; ++bj)
#pragma unroll
                    for (int n = 0; n < 2; ++n) {
                        const u32x2 w_ = wb[m][bj][n];
                        const f32x4 bs = (f32x4){__uint_as_float(w_.x << 16), __uint_as_float(w_.x & 0xffff0000u), __uint_as_float(w_.y << 16), __uint_as_float(w_.y & 0xffff0000u)};
                        const f32x4 o = bs + acc[ai][bj][m][n] * sc;
                        part += (o[0] * o[0] + o[1] * o[1]) + (o[2] * o[2] + o[3] * o[3]);
                        u32x2 w; w.x = cvt_pk_bf16(o[0], o[1]); w.y = cvt_pk_bf16(o[2], o[3]);
                        *(u32x2*)(xb + off + bj * HALF + n * 16) = w;
                    }
                part += __shfl_xor(part, 16); part += __shfl_xor(part, 32);
                if (fq == 0) ssn[(size_t)row * 16 + u.pn * 4 + wc] = part;
            }
        }
    }
};

struct EpiMlpIn {
    static constexpr bool PERM = true, AFTER_DRAIN = false, MID = false;
    const float* ss; bf16_t* O;
    __device__ __forceinline__ void operator()(const f32x4 (&acc)[2][2][4][2], const Unit& u, int wr, int wc, int fr_, int fq_) const {
        int fr = fr_, fq = fq_; asm volatile("" : "+v"(fr), "+v"(fq));
        const int col0 = u.pn * BM + wc * 32 + 8 * fq;
        float rs8[8]; rows_rstd<16>(ss, u.pm * BM + wr * 64 + fr, fq, 1.0f / 1024.0f, rs8);
#pragma unroll
        for (int ai = 0; ai < 2; ++ai)
#pragma unroll
            for (int m = 0; m < 4; ++m) {
                const int row = u.pm * BM + ai * HALF + wr * 64 + m * 16 + fr;
                const float rs = rs8[ai * 4 + m];
                bf16_t* rowp = O + (size_t)row * 4096 + col0;
#pragma unroll
                for (int bj = 0; bj < 2; ++bj) {
                    f32x4 v0 = acc[ai][bj][m][0] * rs, v1 = acc[ai][bj][m][1] * rs;
#pragma unroll
                    for (int j = 0; j < 4; ++j) { const float a = fmaxf(v0[j], 0.f), b = fmaxf(v1[j], 0.f); v0[j] = a * a; v1[j] = b * b; }
                    u32x4 w; w.x = cvt_pk_bf16(v0[0], v0[1]); w.y = cvt_pk_bf16(v0[2], v0[3]); w.z = cvt_pk_bf16(v1[0], v1[1]); w.w = cvt_pk_bf16(v1[2], v1[3]);
                    *(u32x4*)(rowp + bj * HALF) = w;
                }
                asm volatile("" ::: "memory");
            }
    }
};
template <class Epi, class Sched, bool ALIGN_EPI = false, bool SP2 = false>
__device__ __forceinline__ void gemm_phase(PG8_LAS unsigned char* lds, const Gemm g, const Sched& S, const Epi& E) {
    int tid_ = threadIdx.x; asm volatile("" : "+v"(tid_));
    const int tid = tid_, wid = __builtin_amdgcn_readfirstlane(tid >> 6), lane = tid & 63, wr = wid >> 2, wc = wid & 3, fr = lane & 15, fq = lane >> 4;
    const int K = g.K, nt = K / BK;
    unsigned voffA[2], voffB[2];
#pragma unroll
    for (int i = 0; i < 2; ++i) { int R, C; stage_rc(tid * 16 + i * 8192, R, C); const int Rb = Epi::PERM ? ((R & ~31) + perm32(R & 31)) : R;
        voffA[i] = (unsigned)(R * K + C) * 2u; voffB[i] = (unsigned)(Rb * K + C) * 2u; }
    const size_t kstep = (size_t)(BK * 2);
    const size_t hstep = (size_t)HALF * K * 2;
    const size_t tstep = 2 * hstep;
    const unsigned ldsw = (unsigned)wid * 1024u;
    const int aoff = lds_byte(wr * 64 + fr, fq * 8), boff = lds_byte(wc * 32 + fr, fq * 8);
#define PG8_SA(b, h) (((b) * 2 + (h)) * HTB)
#define PG8_SB(b, h) ((4 + (b) * 2 + (h)) * HTB)
#define PG8_STAGE(bufoff, gbase, voff) do { _Pragma("unroll") for (int _i = 0; _i < 2; ++_i) { unsigned _vo = (voff)[_i]; asm volatile("" : "+v"(_vo)); \
        __builtin_amdgcn_global_load_lds((const unsigned*)((const char*)(gbase) + _vo), (PG8_LAS unsigned*)(lds + (bufoff) + ldsw + _i * 8192), 16, 0, 0); } } while (0)
#define PG8_LDA(dst, b, h) do { _Pragma("unroll") for (int m = 0; m < 4; ++m) _Pragma("unroll") for (int k = 0; k < 2; ++k) dst[m][k] = *(const PG8_LAS bf16x8*)(lds + PG8_SA(b, h) + aoff + m * 2048 + k * 1024); } while (0)
#define PG8_LDB(dst, b, h) do { _Pragma("unroll") for (int n = 0; n < 2; ++n) _Pragma("unroll") for (int k = 0; k < 2; ++k) dst[n][k] = *(const PG8_LAS bf16x8*)(lds + PG8_SB(b, h) + boff + n * 2048 + k * 1024); } while (0)
#define PG8_MMA(ai, bj, At, Bt) do { __builtin_amdgcn_s_setprio(1); _Pragma("unroll") for (int m = 0; m < 4; ++m) _Pragma("unroll") for (int n = 0; n < 2; ++n) _Pragma("unroll") for (int k = 0; k < 2; ++k) \
        acc[ai][bj][m][n] = __builtin_amdgcn_mfma_f32_16x16x32_bf16(Bt[n][k], At[m][k], acc[ai][bj][m][n], 0, 0, 0); __builtin_amdgcn_s_setprio(0); } while (0)
#define PG8_WAIT_V(n) asm volatile("s_waitcnt vmcnt(" #n ")" ::: "memory")
#define PG8_WAIT_L(n) asm volatile("s_waitcnt lgkmcnt(" #n ")" ::: "memory")
#define PG8_BAR __builtin_amdgcn_s_barrier()
#define PG8_SCHED __builtin_amdgcn_sched_barrier(0)
    Unit cur, nxt; int ui = 0;
    if (!S.next(0, cur)) return;
    f32x4 acc[2][2][4][2];
#pragma unroll
    for (int a = 0; a < 2; ++a)
#pragma unroll
        for (int b = 0; b < 2; ++b)
#pragma unroll
            for (int m = 0; m < 4; ++m)
#pragma unroll
                for (int n = 0; n < 2; ++n) acc[a][b][m][n] = (f32x4){0.f, 0.f, 0.f, 0.f};
    bf16x8 At[4][2], B0[2][2], B1[2][2];
    const char* cA = (const char*)g.A + (size_t)cur.pm * tstep; const char* cB = (const char*)g.Bt + (size_t)cur.pn * tstep;
    S.a_ready(cur);
    if constexpr (SP2) {
        PG8_STAGE(PG8_SB(0, 0), cB, voffB); PG8_STAGE(PG8_SB(0, 1), cB + hstep, voffB); PG8_STAGE(PG8_SA(0, 0), cA, voffA); PG8_STAGE(PG8_SA(0, 1), cA + hstep, voffA);
        if (wr == 1) PG8_BAR;
        PG8_WAIT_V(2); PG8_BAR;
        PG8_STAGE(PG8_SB(1, 0), cB + kstep, voffB); PG8_STAGE(PG8_SA(1, 0), cA + kstep, voffA); PG8_STAGE(PG8_SB(1, 1), cB + hstep + kstep, voffB);
        PG8_WAIT_V(6); PG8_BAR;
    } else {
        PG8_STAGE(PG8_SB(0, 0), cB, voffB); PG8_STAGE(PG8_SA(0, 0), cA, voffA); PG8_STAGE(PG8_SB(0, 1), cB + hstep, voffB); PG8_STAGE(PG8_SA(0, 1), cA + hstep, voffA);
        if (wr == 1) PG8_BAR;
        PG8_WAIT_V(4); PG8_BAR;
        PG8_STAGE(PG8_SB(1, 0), cB + kstep, voffB); PG8_STAGE(PG8_SA(1, 0), cA + kstep, voffA); PG8_STAGE(PG8_SB(1, 1), cB + hstep + kstep, voffB);
        PG8_WAIT_V(6); PG8_BAR;
    }
    for (;;) {
        const bool has_next = S.next(ui + 1, nxt);
        const char* nA = has_next ? (const char*)g.A + (size_t)nxt.pm * tstep : cA; const char* nB = has_next ? (const char*)g.Bt + (size_t)nxt.pn * tstep : cB;
        for (int t = 0; t < nt; t += 2) {
            if constexpr (Epi::MID) { if (t == (nt >> 1)) E.mid(acc, cur, wr, wc, fr, fq); }
            const bool last = (t == nt - 2);
            const char* a1 = cA + (size_t)(t + 1) * kstep;
            const char* a2 = last ? nA : cA + (size_t)(t + 2) * kstep; const char* b2 = last ? nB : cB + (size_t)(t + 2) * kstep;
            const char* a3 = a2 + kstep; const char* b3 = b2 + kstep;
            if (last && has_next) S.a_ready(nxt);
            if constexpr (SP2) {
            PG8_LDB(B0, 0, 0); PG8_LDB(B1, 0, 1); PG8_SCHED; PG8_LDA(At, 0, 0); PG8_STAGE(PG8_SA(1, 1), a1 + hstep, voffA);
            PG8_WAIT_V(8); PG8_WAIT_L(0); PG8_BAR; PG8_MMA(0, 0, At, B0); PG8_MMA(0, 1, At, B1); PG8_BAR; PG8_SCHED;
            PG8_LDA(At, 0, 1); PG8_STAGE(PG8_SB(0, 0), b2, voffB); PG8_STAGE(PG8_SB(0, 1), b2 + hstep, voffB); PG8_STAGE(PG8_SA(0, 0), a2, voffA);
            PG8_WAIT_V(8); PG8_WAIT_L(0); PG8_BAR; PG8_MMA(1, 0, At, B0); PG8_MMA(1, 1, At, B1); PG8_BAR; PG8_SCHED;
            PG8_LDB(B0, 1, 0); PG8_LDB(B1, 1, 1); PG8_SCHED; PG8_LDA(At, 1, 0); PG8_STAGE(PG8_SA(0, 1), a2 + hstep, voffA);
            PG8_WAIT_V(8); PG8_WAIT_L(0); PG8_BAR; PG8_MMA(0, 0, At, B0); PG8_MMA(0, 1, At, B1); PG8_BAR; PG8_SCHED;
            PG8_LDA(At, 1, 1); PG8_STAGE(PG8_SB(1, 0), b3, voffB); PG8_STAGE(PG8_SB(1, 1), b3 + hstep, voffB); PG8_STAGE(PG8_SA(1, 0), a3, voffA);
            PG8_WAIT_V(8); PG8_WAIT_L(0); PG8_BAR; PG8_MMA(1, 0, At, B0); PG8_MMA(1, 1, At, B1); PG8_BAR; PG8_SCHED;
            } else {
            PG8_LDB(B0, 0, 0); PG8_SCHED; PG8_LDA(At, 0, 0); PG8_STAGE(PG8_SA(1, 1), a1 + hstep, voffA);
            PG8_WAIT_L(8); PG8_BAR; PG8_WAIT_L(0); PG8_MMA(0, 0, At, B0); PG8_BAR; PG8_SCHED;
            PG8_LDB(B1, 0, 1); PG8_STAGE(PG8_SB(0, 0), b2, voffB);
            PG8_BAR; PG8_WAIT_L(0); PG8_MMA(0, 1, At, B1); PG8_BAR;
            PG8_LDA(At, 0, 1); PG8_STAGE(PG8_SA(0, 0), a2, voffA);
            PG8_BAR; PG8_WAIT_L(0); PG8_MMA(1, 0, At, B0); PG8_BAR; PG8_SCHED;
            PG8_STAGE(PG8_SB(0, 1), b2 + hstep, voffB);
            PG8_WAIT_V(6); PG8_BAR; PG8_MMA(1, 1, At, B1); PG8_BAR;
            PG8_LDB(B0, 1, 0); PG8_SCHED; PG8_LDA(At, 1, 0); PG8_STAGE(PG8_SA(0, 1), a2 + hstep, voffA);
            PG8_WAIT_L(8); PG8_BAR; PG8_WAIT_L(0); PG8_MMA(0, 0, At, B0); PG8_BAR; PG8_SCHED;
            PG8_LDB(B1, 1, 1); PG8_STAGE(PG8_SB(1, 0), b3, voffB);
            PG8_BAR; PG8_WAIT_L(0); PG8_MMA(0, 1, At, B1); PG8_BAR;
            PG8_LDA(At, 1, 1); PG8_STAGE(PG8_SA(1, 0), a3, voffA);
            PG8_BAR; PG8_WAIT_L(0); PG8_MMA(1, 0, At, B0); PG8_BAR; PG8_SCHED;
            PG8_STAGE(PG8_SB(1, 1), b3 + hstep, voffB);
            PG8_WAIT_V(6); PG8_BAR; PG8_MMA(1, 1, At, B1); PG8_BAR;
            }
        }
        if constexpr (ALIGN_EPI) { if (wr == 0) PG8_BAR; }
        if constexpr (!Epi::AFTER_DRAIN) { E(acc, cur, wr, wc, fr, fq); S.done(cur); }
        if (!has_next) break;
#pragma unroll
        for (int a = 0; a < 2; ++a)
#pragma unroll
            for (int b = 0; b < 2; ++b)
#pragma unroll
                for (int m = 0; m < 4; ++m)
#pragma unroll
                    for (int n = 0; n < 2; ++n) acc[a][b][m][n] = (f32x4){0.f, 0.f, 0.f, 0.f};
        cur = nxt; cA = nA; cB = nB; ++ui;
        if constexpr (ALIGN_EPI) { if (wr == 1) PG8_BAR; }
    }
    PG8_WAIT_V(0);
    if constexpr (!ALIGN_EPI) { if (wr == 0) PG8_BAR; }
    PG8_BAR;
    if constexpr (Epi::AFTER_DRAIN) { E.fused(acc, cur, wr, wc, fr, fq, lds, wid, lane); S.done(cur); }
#undef PG8_SA
#undef PG8_SB
#undef PG8_STAGE
#undef PG8_LDA
#undef PG8_LDB
#undef PG8_MMA
#undef PG8_WAIT_V
#undef PG8_WAIT_L
#undef PG8_BAR
#undef PG8_SCHED
}
}
#include <hip/hip_bf16.h>
#include <cmath>
namespace attn_body {
using bf16=__hip_bfloat16;
using bf16x8=__attribute__((ext_vector_type(8)))short;
using s16x4=__attribute__((ext_vector_type(4)))short;
using f32x16=__attribute__((ext_vector_type(16)))float;
using u32x4=__attribute__((ext_vector_type(4)))unsigned;
constexpr int SEQ=4096,D=64,QP=512,KP=128,OP=1024;
constexpr int NW=8,QBLK=32,QB=QBLK*NW,KVBLK=64,NQB=SEQ/QB;
constexpr int ATTN_UNIT_ROWS=QB;
__device__ __forceinline__ int crow(int r,int hi){return (r&3)+8*(r>>2)+4*hi;}
#define SBAR() __builtin_amdgcn_sched_barrier(0)
__device__ __forceinline__ void cmask(f32x16&p0,f32x16&p1,int jb,int qrel,int hi){
  const float NEG=-INFINITY; int kb=64*jb+4*hi;
  #pragma unroll
  for(int r=0;r<16;++r){int kv=kb+(r&3)+8*(r>>2); if(kv>qrel)p0[r]=NEG; if(kv+32>qrel)p1[r]=NEG;}
}

constexpr int NSLOT=3, SLOTB=8192;
constexpr int LDS_K=0, LDS_V=NSLOT*SLOTB, LDS_WS=2*NSLOT*SLOTB, LDS_OST=LDS_WS+NW*64*4, LDS_BYTES=LDS_OST+NW*4096;
constexpr float C2=0.125f*1.4426950408889634f;
__device__ __forceinline__ void glds16(const void*gsrc,unsigned lds_dst){unsigned keep;
  asm volatile("s_mov_b32 %0, m0\n\ts_mov_b32 m0, %2\n\ts_nop 0\n\tglobal_load_lds_dwordx4 %1, off\n\ts_mov_b32 m0, %0":"=&s"(keep):"v"(gsrc),"s"(lds_dst):"memory");}
__device__ __forceinline__ float max3f(float a,float b,float c){float r;asm("v_max3_f32 %0, %1, %2, %3":"=v"(r):"v"(a),"v"(b),"v"(c));return r;}
__device__ __forceinline__ float max2f(float a,float b){float r;asm("v_max_f32_e32 %0, %1, %2":"=v"(r):"v"(a),"v"(b));return r;}
__device__ __forceinline__ float fadd_s(float a,float b){float r;asm("v_add_f32_e32 %0, %1, %2":"=v"(r):"v"(a),"v"(b));return r;}
__device__ __forceinline__ float fsub_s(float a,float b){float r;asm("v_sub_f32_e32 %0, %1, %2":"=v"(r):"v"(a),"v"(b));return r;}
typedef float f32x2_t __attribute__((ext_vector_type(2))); typedef __bf16 bf16x2_t __attribute__((ext_vector_type(2)));
__device__ __forceinline__ unsigned cvtpk_s(float lo,float hi){f32x2_t v={lo,hi};bf16x2_t b=__builtin_convertvector(v,bf16x2_t);return __builtin_bit_cast(unsigned,b);}
#define WAIT_BAR(N) asm volatile("s_waitcnt vmcnt(" #N ") lgkmcnt(0)\n\ts_barrier":::"memory")

__device__ __forceinline__ void qkt(f32x16&p0,f32x16&p1,const char*Kslot,const bf16x8*qr,const f32x16&negm,int r32,int hi){
  const char*kb=Kslot+hi*1024+r32*16;
  #pragma unroll
  for(int d0=0;d0<4;++d0){
    const bf16x8 b0=*reinterpret_cast<const bf16x8*>(kb+d0*2048);
    const bf16x8 b1=*reinterpret_cast<const bf16x8*>(kb+d0*2048+512);
    if(d0==0){p0=__builtin_amdgcn_mfma_f32_32x32x16_bf16(b0,qr[0],negm,0,0,0);p1=__builtin_amdgcn_mfma_f32_32x32x16_bf16(b1,qr[0],negm,0,0,0);}
    else{p0=__builtin_amdgcn_mfma_f32_32x32x16_bf16(b0,qr[d0],p0,0,0,0);p1=__builtin_amdgcn_mfma_f32_32x32x16_bf16(b1,qr[d0],p1,0,0,0);}}
}
typedef __attribute__((address_space(3))) const char* lds_cptr;
typedef short v4i16_t __attribute__((ext_vector_type(4)));
__device__ __forceinline__ void kload8(bf16x8*kf,lds_cptr kp){
  kf[0]=*(const __attribute__((address_space(3))) bf16x8*)(kp);      kf[1]=*(const __attribute__((address_space(3))) bf16x8*)(kp+512);
  kf[2]=*(const __attribute__((address_space(3))) bf16x8*)(kp+2048); kf[3]=*(const __attribute__((address_space(3))) bf16x8*)(kp+2560);
  kf[4]=*(const __attribute__((address_space(3))) bf16x8*)(kp+4096); kf[5]=*(const __attribute__((address_space(3))) bf16x8*)(kp+4608);
  kf[6]=*(const __attribute__((address_space(3))) bf16x8*)(kp+6144); kf[7]=*(const __attribute__((address_space(3))) bf16x8*)(kp+6656);
}
__device__ __forceinline__ void kload2(bf16x8*kf,lds_cptr kp,int j){ kf[2*j]=*(const __attribute__((address_space(3))) bf16x8*)(kp+j*2048); kf[2*j+1]=*(const __attribute__((address_space(3))) bf16x8*)(kp+j*2048+512); }
__device__ __forceinline__ s16x4 vtr(lds_cptr p){ return __builtin_bit_cast(s16x4,__builtin_amdgcn_ds_read_tr16_b64_v4i16((__attribute__((address_space(3))) v4i16_t*)p)); }
__device__ __forceinline__ float rowmax(const f32x16&p0,const f32x16&p1){
  float a=max3f(p0[0],p0[1],p1[0]),b=max3f(p0[2],p0[3],p1[1]);a=max3f(a,p1[2],p1[3]);
  #pragma unroll
  for(int r=4;r<16;r+=4){a=max3f(a,p0[r],p0[r+1]);b=max3f(b,p0[r+2],p0[r+3]);a=max3f(a,p1[r],p1[r+1]);b=max3f(b,p1[r+2],p1[r+3]);}
  const float m=max2f(a,b);
  auto rr=__builtin_amdgcn_permlane32_swap(__float_as_uint(m),__float_as_uint(m),false,false);
  return max2f(__uint_as_float(rr[0]),__uint_as_float(rr[1]));
}
__device__ __forceinline__ void pv(f32x16*o,int vb,bf16x8 pa0,bf16x8 pa1,bf16x8 pa2,bf16x8 pa3){
  #pragma unroll
  for(int d0=0;d0<2;++d0){s16x4 lo[4],hi[4];
    #pragma unroll
    for(int ks=0;ks<4;++ks){
      asm volatile("ds_read_b64_tr_b16 %0,%1 offset:%c2":"=&v"(lo[ks]):"v"(vb),"i"(d0*4096+ks*1024):"memory");
      asm volatile("ds_read_b64_tr_b16 %0,%1 offset:%c2":"=&v"(hi[ks]):"v"(vb),"i"(d0*4096+ks*1024+512):"memory");}
    asm volatile("s_waitcnt lgkmcnt(0)":::"memory");SBAR();
    #define PK(k) (bf16x8){lo[k][0],lo[k][1],lo[k][2],lo[k][3],hi[k][0],hi[k][1],hi[k][2],hi[k][3]}
    o[d0]=__builtin_amdgcn_mfma_f32_32x32x16_bf16(pa0,PK(0),o[d0],0,0,0);
    o[d0]=__builtin_amdgcn_mfma_f32_32x32x16_bf16(pa1,PK(1),o[d0],0,0,0);
    o[d0]=__builtin_amdgcn_mfma_f32_32x32x16_bf16(pa2,PK(2),o[d0],0,0,0);
    o[d0]=__builtin_amdgcn_mfma_f32_32x32x16_bf16(pa3,PK(3),o[d0],0,0,0);
    #undef PK
  }
}

#ifndef ATTN_STORE16
#define ATTN_STORE16(p,v) (*(u32x4*)(p)=(v))
#endif
template<int THRL> __device__ __forceinline__ void attn_unit(int b,int h,int qb,const bf16*Q,const bf16*__restrict__ K,const bf16*__restrict__ V,bf16*O,float*SSQ,char*shm){
  int tid_=threadIdx.x; asm volatile("":"+v"(tid_));
  const int tid=tid_,lane=tid&63,r32=lane&31,hi=lane>>5; const int wid=__builtin_amdgcn_readfirstlane(tid>>6);
  const long rowbase=(long)b*SEQ; const int q0=qb*QB;
  const bf16*Qw=Q+(rowbase+q0+wid*QBLK)*QP+h*D;
  const bf16*Kh=K+rowbase*KP+(h>>2)*D,*Vh=V+rowbase*KP+(h>>2)*D;
  const unsigned lds0=(unsigned)(uintptr_t)shm;
  float*wsf=(float*)(shm+LDS_WS)+wid*64;
  const bf16*ksrc=Kh+(long)lane*KP+wid*8;
  const bf16*vsrc=Vh+(long)(16*(wid&3)+(lane>>2))*KP+(wid>>2)*32+(lane&3)*8;
  const unsigned kdst=lds0+LDS_K+wid*1024, vdst=lds0+LDS_V+wid*1024;
  #define DMA_K(t,slot) glds16(ksrc+(long)(t)*KVBLK*KP,(unsigned)__builtin_amdgcn_readfirstlane(kdst+(slot)))
  #define DMA_V(t,slot) glds16(vsrc+(long)(t)*KVBLK*KP,(unsigned)__builtin_amdgcn_readfirstlane(vdst+(slot)))
  const int vb0=(int)(lds0+LDS_V)+((lane>>4)&1)*32+(lane&3)*8+(4*hi+((lane&15)>>2))*64;
  const char*Kbase=shm+LDS_K; bf16x8 kf[8];
  const lds_cptr shm3=(lds_cptr)shm; const lds_cptr kp0=shm3+LDS_K+hi*1024+r32*16; const lds_cptr vp0=shm3+LDS_V+((lane>>4)&1)*32+(lane&3)*8+(4*hi+((lane&15)>>2))*64;
  const int NT=SEQ/KVBLK;
  DMA_K(0,0);DMA_V(0,0);DMA_K(1,SLOTB);
  bf16x8 qr[4];
  #pragma unroll
  for(int d0=0;d0<4;++d0)qr[d0]=*reinterpret_cast<const bf16x8*>(&Qw[(long)r32*QP+d0*16+hi*8]);
  float mhat=0.f,l_reg=0.f;f32x16 o[2];o[0]=f32x16{};o[1]=f32x16{};f32x16 negm=f32x16{};asm volatile("":"+v"(negm));
  #define CMASK(P0,P1,t) do{}while(0)
  bool resc=false;
  #define START(P0,P1) do{ const float rm=rowmax(P0,P1); resc=false; \
    { const float dl=rm; mhat=fadd_s(mhat,dl); \
      _Pragma("unroll") for(int r=0;r<16;++r){P0[r]=fsub_s(P0[r],dl);P1[r]=fsub_s(P1[r],dl);} \
      _Pragma("unroll") for(int r=0;r<16;++r)negm[r]=-mhat; asm volatile("":"+v"(negm)); } \
    _Pragma("unroll") for(int r=0;r<16;++r)P0[r]=__builtin_amdgcn_exp2f(P0[r]); }while(0)
  #define RESC() do{ if(resc){ asm volatile("s_waitcnt lgkmcnt(0)":::"memory"); \
      _Pragma("unroll") for(int d_=0;d_<2;++d_) _Pragma("unroll") for(int r=0;r<16;++r)o[d_][r]*=wsf[crow(r,hi)]; } }while(0)
  f32x16 pA0,pA1,pB0,pB1;
  int sl_prev=0,sl_cur=0,sl_next=SLOTB;
  #define ROT() do{sl_prev=sl_cur;sl_cur=sl_next;sl_next=(sl_next==(NSLOT-1)*SLOTB)?0:sl_next+SLOTB;}while(0)
  DMA_K(2,2*SLOTB);
  WAIT_BAR(3);
  qkt(pA0,pA1,Kbase,qr,negm,r32,hi);asm volatile("s_nop 15\n\ts_nop 7":"+v"(pA0),"+v"(pA1));CMASK(pA0,pA1,0);
  START(pA0,pA1);
  _Pragma("unroll") for(int r=0;r<16;++r)pA1[r]=__builtin_amdgcn_exp2f(pA1[r]);
  WAIT_BAR(0);
  DMA_K(3,0);DMA_V(1,SLOTB);
  ROT();
  kload8(kf,kp0+sl_cur);
  WAIT_BAR(2);
  s16x4 vlo[8],vhi[8]; u32x4 pw0,pw1,pw2,pw3;
  #define PKW(P,B) cvtpk_s(P[B],P[B+1])
  #define PAF(k) __builtin_bit_cast(bf16x8,pw##k)
  #define VFR(i) (bf16x8){vlo[i][0],vlo[i][1],vlo[i][2],vlo[i][3],vhi[i][0],vhi[i][1],vhi[i][2],vhi[i][3]}
  #define PIN(x) asm volatile("":"+v"(x))
  #define MX3(a,b,c) __builtin_fmaxf(__builtin_fmaxf((a),(b)),(c))
  #define GAPA(MF,A0,A1,A2,A3,W0,W1,PW) do{ MF; sacc+=A0; sacc+=A1; sacc+=A2; sacc+=A3; PIN(sacc); W0; W1; PIN(PW); SBAR(); }while(0)
  #define EX(v) __builtin_amdgcn_exp2f(v)
  #define GAPB(MF,X,B) do{ MF; X[B]=EX(X[B]); X[B+1]=EX(X[B+1]); X[B+2]=EX(X[B+2]); X[B+3]=EX(X[B+3]); PIN(X); SBAR(); }while(0)
  #define VRD(i) do{ vlo[i]=vtr(vp_+(((i)>>2)*4096+((i)&3)*1024)); vhi[i]=vtr(vp_+(((i)>>2)*4096+((i)&3)*1024+512)); }while(0)
  #define KRD(G,j) do{ if(G){ kload2(kf,kp0+sl_next,j); SBAR(); } }while(0)
  #define STEP(C0,C1,P0,P1,t,GK,GV,GL) do{ SBAR(); \
    const lds_cptr vp_=vp0+sl_prev; \
    VRD(0); SBAR(); float sacc=(P0[0]+P0[1]); \
    GAPA(C0=__builtin_amdgcn_mfma_f32_32x32x16_bf16(kf[0],qr[0],negm,0,0,0), P0[2],P0[3],P0[4],P0[5],     pw0[0]=PKW(P0,0), pw0[1]=PKW(P0,2), pw0); \
    VRD(4); SBAR(); GAPA(C1=__builtin_amdgcn_mfma_f32_32x32x16_bf16(kf[1],qr[0],negm,0,0,0), P0[6],P0[7],P0[8],P0[9],     pw0[2]=PKW(P0,4), pw0[3]=PKW(P0,6), pw0); \
    VRD(1); SBAR(); GAPA(C0=__builtin_amdgcn_mfma_f32_32x32x16_bf16(kf[2],qr[1],C0,0,0,0),   P0[10],P0[11],P0[12],P0[13], pw1[0]=PKW(P0,8), pw1[1]=PKW(P0,10), pw1); \
    VRD(5); SBAR(); GAPA(C1=__builtin_amdgcn_mfma_f32_32x32x16_bf16(kf[3],qr[1],C1,0,0,0),   P0[14],P0[15],P1[0],P1[1],   pw1[2]=PKW(P0,12),pw1[3]=PKW(P0,14), pw1); \
    VRD(2); SBAR(); GAPA(C0=__builtin_amdgcn_mfma_f32_32x32x16_bf16(kf[4],qr[2],C0,0,0,0),   P1[2],P1[3],P1[4],P1[5],     pw2[0]=PKW(P1,0), pw2[1]=PKW(P1,2), pw2); \
    VRD(6); SBAR(); GAPA(C1=__builtin_amdgcn_mfma_f32_32x32x16_bf16(kf[5],qr[2],C1,0,0,0),   P1[6],P1[7],P1[8],P1[9],     pw2[2]=PKW(P1,4), pw2[3]=PKW(P1,6), pw2); \
    VRD(3); SBAR(); GAPA(C0=__builtin_amdgcn_mfma_f32_32x32x16_bf16(kf[6],qr[3],C0,0,0,0),   P1[10],P1[11],P1[12],P1[13], pw3[0]=PKW(P1,8), pw3[1]=PKW(P1,10), pw3); \
    VRD(7); SBAR(); GAPA(C1=__builtin_amdgcn_mfma_f32_32x32x16_bf16(kf[7],qr[3],C1,0,0,0),   P1[14],P1[15],0.f,0.f,       pw3[2]=PKW(P1,12),pw3[3]=PKW(P1,14), pw3); \
    l_reg+=sacc; \
    if(GK){DMA_K((t)+3,sl_cur);} if(GV){DMA_V((t)+1,sl_next);} \
    CMASK(C0,C1,t); \
    { float a=MX3(C0[0],C0[1],C1[0]),b=MX3(C0[2],C0[3],C1[1]); a=MX3(a,C1[2],C1[3]); \
      _Pragma("unroll") for(int r=4;r<16;r+=4){a=MX3(a,C0[r],C0[r+1]);b=MX3(b,C0[r+2],C0[r+3]);a=MX3(a,C1[r],C1[r+1]);b=MX3(b,C1[r+2],C1[r+3]);} \
      float rm=__builtin_fmaxf(a,b); { auto rr=__builtin_amdgcn_permlane32_swap(__float_as_uint(rm),__float_as_uint(rm),false,false); rm=__builtin_fmaxf(__uint_as_float(rr[0]),__uint_as_float(rr[1])); } \
      resc=false; \
      if(__builtin_expect(__any(rm>(float)THRL),0)){ const float dl=__builtin_fmaxf(rm,0.f); mhat+=dl; \
        _Pragma("unroll") for(int r=0;r<16;++r){C0[r]-=dl;C1[r]-=dl;} \
        _Pragma("unroll") for(int r=0;r<16;++r)negm[r]=-mhat; asm volatile("":"+v"(negm)); \
        const float f=__builtin_amdgcn_exp2f(-dl); l_reg*=f; if(hi==0)wsf[r32]=f; resc=true; } } \
    SBAR(); \
    GAPB(o[0]=__builtin_amdgcn_mfma_f32_32x32x16_bf16(PAF(0),VFR(0),o[0],0,0,0), C0,0); \
    GAPB(o[1]=__builtin_amdgcn_mfma_f32_32x32x16_bf16(PAF(0),VFR(4),o[1],0,0,0), C0,4); \
    KRD(GL,0); GAPB(o[0]=__builtin_amdgcn_mfma_f32_32x32x16_bf16(PAF(1),VFR(1),o[0],0,0,0), C0,8); \
    KRD(GL,1); GAPB(o[1]=__builtin_amdgcn_mfma_f32_32x32x16_bf16(PAF(1),VFR(5),o[1],0,0,0), C0,12); \
    KRD(GL,2); GAPB(o[0]=__builtin_amdgcn_mfma_f32_32x32x16_bf16(PAF(2),VFR(2),o[0],0,0,0), C1,0); \
    KRD(GL,3); GAPB(o[1]=__builtin_amdgcn_mfma_f32_32x32x16_bf16(PAF(2),VFR(6),o[1],0,0,0), C1,4); \
    GAPB(o[0]=__builtin_amdgcn_mfma_f32_32x32x16_bf16(PAF(3),VFR(3),o[0],0,0,0), C1,8); \
    GAPB(o[1]=__builtin_amdgcn_mfma_f32_32x32x16_bf16(PAF(3),VFR(7),o[1],0,0,0), C1,12); \
    }while(0)
  int t=1;
  #undef CMASK
  #define CMASK(P0,P1,t) do{}while(0)
  for(;t+5<NT;t+=2){
    STEP(pB0,pB1,pA0,pA1,t,true,true,true);     WAIT_BAR(2); RESC(); ROT();
    STEP(pA0,pA1,pB0,pB1,t+1,true,true,true);   WAIT_BAR(2); RESC(); ROT();
  }
  #undef CMASK
  #define CMASK(P0,P1,t) do{}while(0)
  #define ENDW(tt) do{ if((tt)+3<NT){WAIT_BAR(2);} else if((tt)+2<NT){WAIT_BAR(1);} else {WAIT_BAR(0);} }while(0)
  for(;t+1<NT;t+=2){
    STEP(pB0,pB1,pA0,pA1,t,(t+3<NT),(t+1<NT),(t+1<NT));       ENDW(t);   RESC(); ROT();
    STEP(pA0,pA1,pB0,pB1,t+1,(t+4<NT),(t+2<NT),(t+2<NT));     ENDW(t+1); RESC(); ROT();
  }
  STEP(pB0,pB1,pA0,pA1,NT-1,false,false,false); RESC();
  { float sacc=pB0[0]+pB0[1]; _Pragma("unroll") for(int r=2;r<16;++r)sacc+=pB0[r]; _Pragma("unroll") for(int r=0;r<16;++r)sacc+=pB1[r]; l_reg+=sacc;
    pw0=(u32x4){PKW(pB0,0),PKW(pB0,2),PKW(pB0,4),PKW(pB0,6)};pw1=(u32x4){PKW(pB0,8),PKW(pB0,10),PKW(pB0,12),PKW(pB0,14)};pw2=(u32x4){PKW(pB1,0),PKW(pB1,2),PKW(pB1,4),PKW(pB1,6)};pw3=(u32x4){PKW(pB1,8),PKW(pB1,10),PKW(pB1,12),PKW(pB1,14)};
    SBAR(); pv(o,vb0+sl_cur,PAF(0),PAF(1),PAF(2),PAF(3)); }
  #undef PKW
  #undef PAF
  #undef VFR
  #undef PIN
  #undef MX3
  #undef GAPA
  #undef GAPB
  #undef EX
  #undef VRD
  #undef KRD
  #undef STEP
  #undef ENDW
  {auto rr=__builtin_amdgcn_permlane32_swap(__float_as_uint(l_reg),__float_as_uint(l_reg),false,false);l_reg=__uint_as_float(rr[0])+__uint_as_float(rr[1]);}
  if(hi==0)wsf[32+r32]=l_reg;asm volatile("s_waitcnt lgkmcnt(0)":::"memory");
  float rli[16];
  #pragma unroll
  for(int r=0;r<16;++r)rli[r]=__builtin_amdgcn_rcpf(wsf[32+crow(r,hi)]);
  bf16*Ow=O+(rowbase+q0+wid*QBLK)*OP+h*D; float*SSw=SSQ+(rowbase+q0+wid*QBLK)*8+h;
  { bf16*stg=(bf16*)(shm+LDS_OST)+wid*2048;
    #pragma unroll
    for(int r=0;r<16;++r){const int orow=crow(r,hi);
      #pragma unroll
      for(int d0=0;d0<2;++d0)stg[orow*64+d0*32+r32]=__float2bfloat16(o[d0][r]*rli[r]);}
    asm volatile("s_waitcnt lgkmcnt(0)":::"memory");
    #pragma unroll
    for(int i=0;i<4;++i){const int row=i*8+(lane>>3),ch=lane&7; const u32x4 v=*(const u32x4*)(stg+row*64+ch*8); ATTN_STORE16(Ow+(long)row*OP+ch*8,v);
      float sq=0.f;
      #pragma unroll
      for(int j=0;j<4;++j){const float lo=__uint_as_float(v[j]<<16),hi2=__uint_as_float(v[j]&0xffff0000u); sq+=lo*lo+hi2*hi2;}
      sq+=__shfl_xor(sq,1);sq+=__shfl_xor(sq,2);sq+=__shfl_xor(sq,4);
      if(ch==0)SSw[(long)row*8]=sq;} }
  asm volatile("s_waitcnt lgkmcnt(0)\n\ts_barrier":::"memory");
  #undef DMA_K
  #undef DMA_V
  #undef CMASK
  #undef START
  #undef RESC
  #undef ROT
}
constexpr int ATTN_LDS_BYTES=LDS_BYTES;
#undef SBAR
#undef WAIT_BAR
}

constexpr int BATCH = 4, SEQ = 4096, DM = 1024, DEPTH = 4, FF = 4096, INW = 2304;
constexpr int M = BATCH * SEQ;
constexpr size_t MiB = 1u << 20;
constexpr size_t WS_COSA = 0, WS_SINA = 4096, WS_COSB = 8192, WS_SINB = 8192 + 131072;
constexpr size_t WS_BAR = 524288, BAR_BYTES = 16384;
constexpr size_t WS_SS = 1 * MiB;
constexpr size_t WS_W = 3 * MiB;
constexpr size_t W_LAYER = 4718592 + 2 * MiB + 8 * MiB + 8 * MiB;
constexpr size_t WS_XB = 93 * MiB;
constexpr size_t WS_H = 125 * MiB;
constexpr size_t WS_QA = 125 * MiB, WS_KA = 141 * MiB, WS_VA = 145 * MiB, WS_QB = 149 * MiB, WS_KB = 165 * MiB, WS_VB = 181 * MiB, WS_Y = 197 * MiB;
constexpr size_t WS_END = 253 * MiB;
static_assert(WS_W + 4 * W_LAYER <= WS_XB, "ws map");
constexpr int LDS_BYTES = 139264;

typedef unsigned short bf16_t;
typedef short bf16x8 __attribute__((ext_vector_type(8)));
typedef short s16x4 __attribute__((ext_vector_type(4)));
typedef float f32x4 __attribute__((ext_vector_type(4)));
typedef float f32x16 __attribute__((ext_vector_type(16)));
typedef unsigned u32x2 __attribute__((ext_vector_type(2)));
typedef unsigned u32x4 __attribute__((ext_vector_type(4)));
#define LAS __attribute__((address_space(3)))

struct Params {
    const float* x; const float* norm1; const float* w_in; const float* q_norm; const float* k_norm; const float* out_norm_a; const float* out_norm_b;
    const float* w_out; const float* norm2; const float* w_mlp_in; const float* w_mlp_out; const float* final_norm;
    float* out; unsigned char* ws;
    double frev[24];
};

__device__ __forceinline__ unsigned f2bf(float f) { unsigned u = __builtin_bit_cast(unsigned, f); return (u + 0x7fffu + ((u >> 16) & 1u)) >> 16; }
__device__ __forceinline__ unsigned pk2(float lo, float hi) { return f2bf(lo) | (f2bf(hi) << 16); }
__device__ __forceinline__ float wave_sum(float v) {
#pragma unroll
    for (int o = 1; o < 64; o <<= 1) v += __shfl_xor(v, o);
    return v;
}

__device__ __forceinline__ void transpose_item(const float* W, int K, int N, bf16_t* WT, int k0, int n0, int dst_row0, const float* g0, LAS float* scr, int lane) {
    float wv[32];
#pragma unroll
    for (int i = 0; i < 32; ++i) wv[i] = __builtin_nontemporal_load(W + (size_t)(k0 + 2 * i + (lane >> 5)) * N + n0 + (lane & 31));
    float gv = 1.f; if (g0) gv = g0[lane];
#pragma unroll
    for (int i = 0; i < 32; ++i) { const int kk = 2 * i + (lane >> 5); const float gk = __shfl(gv, kk); scr[kk * 33 + (lane & 31)] = wv[i] * gk; }
    asm volatile("s_waitcnt lgkmcnt(0)" ::: "memory");
    const int c = lane & 7;
#pragma unroll
    for (int j = 0; j < 4; ++j) { const int n = (lane >> 3) + 8 * j; const LAS float* s = scr + (8 * c) * 33 + n;
        u32x4 o; o.x = pk2(s[0 * 33], s[1 * 33]); o.y = pk2(s[2 * 33], s[3 * 33]); o.z = pk2(s[4 * 33], s[5 * 33]); o.w = pk2(s[6 * 33], s[7 * 33]);
        *(u32x4*)(WT + (size_t)(dst_row0 + n) * K + k0 + 8 * c) = o; }
    asm volatile("s_waitcnt lgkmcnt(0)" ::: "memory");
}

__device__ __forceinline__ s16x4 vtr(const LAS char* p) { typedef short v4i16_t __attribute__((ext_vector_type(4))); return __builtin_bit_cast(s16x4, __builtin_amdgcn_ds_read_tr16_b64_v4i16((LAS v4i16_t*)p)); }
__device__ __forceinline__ unsigned cvtpk(float lo, float hi) { typedef float f2 __attribute__((ext_vector_type(2))); typedef __bf16 b2 __attribute__((ext_vector_type(2))); f2 v = {lo, hi}; b2 b = __builtin_convertvector(v, b2); return __builtin_bit_cast(unsigned, b); }

__device__ __forceinline__ void softmax_block(f32x16& s, float& m, float& l, f32x16 (&o)[2], bool first, bf16x8 (&pf)[2]) {
    float rm = s[0];
#pragma unroll
    for (int r = 1; r < 16; ++r) rm = fmaxf(rm, s[r]);
    rm = fmaxf(rm, __shfl_xor(rm, 32));
    const bool upd = first || (rm - m > 6.0f);
    if (__any(upd)) {
        const float mn = upd ? fmaxf(rm, -64.0f) : m;
        const float alpha = __builtin_amdgcn_exp2f(m - mn);
        m = mn; l *= alpha;
#pragma unroll
        for (int r = 0; r < 16; ++r) { o[0][r] *= alpha; o[1][r] *= alpha; }
    }
    float sum = 0.f;
#pragma unroll
    for (int r = 0; r < 16; ++r) { s[r] = __builtin_amdgcn_exp2f(s[r] - m); sum += s[r]; }
    l += sum;
    u32x4 w0, w1;
    w0.x = cvtpk(s[0], s[1]); w0.y = cvtpk(s[2], s[3]); w0.z = cvtpk(s[4], s[5]); w0.w = cvtpk(s[6], s[7]);
    w1.x = cvtpk(s[8], s[9]); w1.y = cvtpk(s[10], s[11]); w1.z = cvtpk(s[12], s[13]); w1.w = cvtpk(s[14], s[15]);
    pf[0] = __builtin_bit_cast(bf16x8, w0); pf[1] = __builtin_bit_cast(bf16x8, w1);
}

__device__ __forceinline__ void attn_store(f32x16 (&o)[2], float l, bf16_t* yrow  , float* ssrow, int h) {
    const float lt = l + __shfl_xor(l, 32);
    const float inv = 1.0f / lt;
    float q = 0.f;
#pragma unroll
    for (int db = 0; db < 2; ++db)
#pragma unroll
        for (int g = 0; g < 4; ++g) {
            const float a = o[db][4 * g] * inv, b = o[db][4 * g + 1] * inv, c = o[db][4 * g + 2] * inv, d = o[db][4 * g + 3] * inv;
            q += (a * a + b * b) + (c * c + d * d);
            u32x2 w; w.x = cvtpk(a, b); w.y = cvtpk(c, d);
            *(u32x2*)(yrow + 32 * db + 8 * g + 4 * h) = w;
        }
    q += __shfl_xor(q, 32);
    if (h == 0) *ssrow = q;
}

template <int NQ>
__device__ __forceinline__ void attn_a_wave(const bf16_t* QA, const bf16_t* KA, const bf16_t* VA, bf16_t* Y, float* ssa, int b, int head, int row0, LAS char* vst, int lane) {
    const int q = lane & 31, h = lane >> 5, kvh = head >> 2;
    bf16x8 qf[NQ][4];
#pragma unroll
    for (int nq = 0; nq < NQ; ++nq)
#pragma unroll
        for (int ds = 0; ds < 4; ++ds) qf[nq][ds] = *(const bf16x8*)(QA + (size_t)(b * SEQ + row0 + 32 * nq + q) * 512 + head * 64 + 16 * ds + 8 * h);
    f32x16 o[NQ][2]; float m[NQ], l[NQ];
#pragma unroll
    for (int nq = 0; nq < NQ; ++nq) { m[nq] = 0.f; l[nq] = 0.f;
#pragma unroll
        for (int r = 0; r < 16; ++r) { o[nq][0][r] = 0.f; o[nq][1][r] = 0.f; } }
    const bf16_t* Kp = KA + (size_t)(b * SEQ + q) * 128 + kvh * 64 + 8 * h;
    const bf16_t* Vp = VA + (size_t)(b * SEQ + (lane >> 3)) * 128 + kvh * 64 + (lane & 7) * 8;
    const int vw_off = (lane >> 3) * 128 + (((lane & 7) * 16) ^ (((lane >> 4) & 1) << 6));
    const int sw = (lane >> 3) & 1;
    const int trb = (4 * h + ((lane & 15) >> 2)) * 128 + 32 * ((lane >> 4) & 1) + 8 * (lane & 3);
    const LAS char* tr0 = vst + trb + 64 * sw;
    const LAS char* tr1 = vst + trb + 64 * (1 - sw);
    bf16x8 kn[4], vn[4];
#pragma unroll
    for (int i = 0; i < 4; ++i) { kn[i] = *(const bf16x8*)(Kp + 16 * i); vn[i] = *(const bf16x8*)(Vp + (size_t)(8 * i) * 128); }
    for (int kb = 0; kb < SEQ / 32; ++kb) {
        bf16x8 kf[4];
#pragma unroll
        for (int i = 0; i < 4; ++i) { kf[i] = kn[i]; *(LAS bf16x8*)(vst + vw_off + i * 1024) = vn[i]; }
        if (kb + 1 < SEQ / 32) {
            const bf16_t* kp2 = Kp + (size_t)(kb + 1) * 32 * 128; const bf16_t* vp2 = Vp + (size_t)(kb + 1) * 32 * 128;
#pragma unroll
            for (int i = 0; i < 4; ++i) { kn[i] = *(const bf16x8*)(kp2 + 16 * i); vn[i] = *(const bf16x8*)(vp2 + (size_t)(8 * i) * 128); }
        }
        bf16x8 pf[NQ][2];
#pragma unroll
        for (int nq = 0; nq < NQ; ++nq) {
            f32x16 s;
#pragma unroll
            for (int r = 0; r < 16; ++r) s[r] = 0.f;
#pragma unroll
            for (int ds = 0; ds < 4; ++ds) s = __builtin_amdgcn_mfma_f32_32x32x16_bf16(kf[ds], qf[nq][ds], s, 0, 0, 0);
            softmax_block(s, m[nq], l[nq], o[nq], kb == 0, pf[nq]);
        }
#pragma unroll
        for (int s2 = 0; s2 < 2; ++s2)
#pragma unroll
            for (int db = 0; db < 2; ++db) {
                const LAS char* tp = (db == 0 ? tr0 : tr1) + s2 * 2048;
                const s16x4 lo = vtr(tp), hi = vtr(tp + 1024);
                const bf16x8 vf = (bf16x8){lo[0], lo[1], lo[2], lo[3], hi[0], hi[1], hi[2], hi[3]};
#pragma unroll
                for (int nq = 0; nq < NQ; ++nq) o[nq][db] = __builtin_amdgcn_mfma_f32_32x32x16_bf16(vf, pf[nq][s2], o[nq][db], 0, 0, 0);
            }
    }
#pragma unroll
    for (int nq = 0; nq < NQ; ++nq) {
        const size_t row = (size_t)(b * SEQ + row0 + 32 * nq + q);
        attn_store(o[nq], l[nq], Y + row * 1024 + head * 64, ssa + row * 8 + head, h);
    }
}

__device__ __forceinline__ void attn_b_wave(const bf16_t* QB, const bf16_t* KB, const bf16_t* VB, bf16_t* Y, float* ssb, int b, int head, int c, int r, LAS char* vst, int lane) {
    const int q = lane & 31, h = lane >> 5;
    const int qp = 512 * c + r + 16 * q;
    bf16x8 qf[4];
#pragma unroll
    for (int ds = 0; ds < 4; ++ds) qf[ds] = *(const bf16x8*)(QB + (size_t)(b * SEQ + qp) * 512 + head * 64 + 16 * ds + 8 * h);
    f32x16 o[2]; float m = 0.f, l = 0.f;
#pragma unroll
    for (int rr = 0; rr < 16; ++rr) { o[0][rr] = 0.f; o[1][rr] = 0.f; }
    const bf16_t* Kb = KB + (size_t)(b * SEQ) * 512 + head * 64 + (lane & 7) * 8;
    const bf16_t* Vb = VB + (size_t)(b * SEQ) * 512 + head * 64 + (lane & 7) * 8;
    const int vw_off = (lane >> 3) * 128 + (((lane & 7) * 16) ^ (((lane >> 4) & 1) << 6));
    const int kw_off = 4096 + (lane >> 3) * 128 + (((lane & 7) ^ ((lane >> 4) & 7)) << 4);
    const int kr_base = 4096 + q * 128, kr_sw = (q >> 1) & 7;
    const int sw = (lane >> 3) & 1;
    const int trb = (4 * h + ((lane & 15) >> 2)) * 128 + 32 * ((lane >> 4) & 1) + 8 * (lane & 3);
    const LAS char* tr0 = vst + trb + 64 * sw;
    const LAS char* tr1 = vst + trb + 64 * (1 - sw);
    const int base = 512 * c + r;
#define BLK_INFO(i, dil, ks) do { if ((i) < 5) { dil = 16; ks = base - 1024 + 512 * (i); } else if ((i) < 13) { dil = 4; ks = base - 256 + 128 * ((i) - 5); } else { dil = 1; ks = base - 64 + 32 * ((i) - 13); } } while (0)
    bf16x8 kn[4], vn[4];
    { int dil, ks; BLK_INFO(0, dil, ks);
#pragma unroll
      for (int i = 0; i < 4; ++i) {
          int vp = ks + dil * (8 * i + (lane >> 3)); vp = vp < 0 ? 0 : (vp > SEQ - 1 ? SEQ - 1 : vp);
          kn[i] = *(const bf16x8*)(Kb + (size_t)vp * 512); vn[i] = *(const bf16x8*)(Vb + (size_t)vp * 512); } }
    for (int bi = 0; bi < 33; ++bi) {
        int dil, ks; BLK_INFO(bi, dil, ks);
        bf16x8 kf[4];
#pragma unroll
        for (int i = 0; i < 4; ++i) { *(LAS bf16x8*)(vst + (kw_off ^ ((i & 1) << 6)) + i * 1024) = kn[i]; *(LAS bf16x8*)(vst + vw_off + i * 1024) = vn[i]; }
#pragma unroll
        for (int ds = 0; ds < 4; ++ds) kf[ds] = *(const LAS bf16x8*)(vst + kr_base + (((2 * ds + h) ^ kr_sw) << 4));
        if (bi + 1 < 33) {
            int dil2, ks2; BLK_INFO(bi + 1, dil2, ks2);
#pragma unroll
            for (int i = 0; i < 4; ++i) {
                int vp = ks2 + dil2 * (8 * i + (lane >> 3)); vp = vp < 0 ? 0 : (vp > SEQ - 1 ? SEQ - 1 : vp);
                kn[i] = *(const bf16x8*)(Kb + (size_t)vp * 512); vn[i] = *(const bf16x8*)(Vb + (size_t)vp * 512); }
        }
        f32x16 s;
#pragma unroll
        for (int rr = 0; rr < 16; ++rr) s[rr] = 0.f;
#pragma unroll
        for (int ds = 0; ds < 4; ++ds) s = __builtin_amdgcn_mfma_f32_32x32x16_bf16(kf[ds], qf[ds], s, 0, 0, 0);
        const int lim = 64 * dil;
        const int lo = (-lim > -qp) ? -lim : -qp, hi_ = (lim < SEQ - 1 - qp) ? lim : SEQ - 1 - qp;
        const int e1 = ks + dil * 4 * h - qp - lo; const unsigned span = (unsigned)(hi_ - lo);
#pragma unroll
        for (int rr = 0; rr < 16; ++rr) {
            const unsigned x = (unsigned)(e1 + dil * ((rr & 3) + 8 * (rr >> 2)));
            s[rr] = (x <= span) ? s[rr] : -1e30f;
        }
        bf16x8 pf[2];
        softmax_block(s, m, l, o, bi == 0, pf);
#pragma unroll
        for (int s2 = 0; s2 < 2; ++s2)
#pragma unroll
            for (int db = 0; db < 2; ++db) {
                const LAS char* tp = (db == 0 ? tr0 : tr1) + s2 * 2048;
                const s16x4 lo = vtr(tp), hi = vtr(tp + 1024);
                const bf16x8 vf = (bf16x8){lo[0], lo[1], lo[2], lo[3], hi[0], hi[1], hi[2], hi[3]};
                o[db] = __builtin_amdgcn_mfma_f32_32x32x16_bf16(vf, pf[s2], o[db], 0, 0, 0);
            }
    }
#undef BLK_INFO
    const size_t row = (size_t)(b * SEQ + qp);
    attn_store(o, l, Y + row * 1024 + 512 + head * 64, ssb + row * 8 + head, h);
}


constexpr int BST_OFF = 65536, BST_M = BST_OFF + 65536, BST_L = BST_M + 2048, BST_END = BST_L + 4096;
__device__ __forceinline__ void attn_b_task(const bf16_t* QB, const bf16_t* KB, const bf16_t* VB, bf16_t* Y, float* ssb, int b, int head, int c, int pat, int j, LAS char* vst, LAS char* lds0, int lane) {
    const int q = lane & 31, h = lane >> 5;
    const int dil = (pat == 0) ? 16 : ((pat == 1) ? 4 : 1);
    const int qoff0 = (pat == 0) ? j : ((pat == 1) ? ((j & 3) + 128 * (j >> 2)) : 32 * j);
    const int qidx = qoff0 + dil * q, qp = 512 * c + qidx;
    bf16x8 qf[4];
#pragma unroll
    for (int ds = 0; ds < 4; ++ds) qf[ds] = *(const bf16x8*)(QB + (size_t)(b * SEQ + qp) * 512 + head * 64 + 16 * ds + 8 * h);
    const bf16_t* Kb = KB + (size_t)(b * SEQ) * 512 + head * 64 + (lane & 7) * 8;
    const bf16_t* Vb = VB + (size_t)(b * SEQ) * 512 + head * 64 + (lane & 7) * 8;
    const int ks0 = 512 * c + qoff0 - 64 * dil;
    bf16x8 kn[4], vn[4];
#pragma unroll
    for (int i = 0; i < 4; ++i) {
        int vp = ks0 + dil * (8 * i + (lane >> 3)); vp = vp < 0 ? 0 : (vp > SEQ - 1 ? SEQ - 1 : vp);
        kn[i] = *(const bf16x8*)(Kb + (size_t)vp * 512); vn[i] = *(const bf16x8*)(Vb + (size_t)vp * 512); }
    f32x16 o[2]; float m = 0.f, l = 0.f;
    const int swz = (qidx ^ (qidx >> 4)) & 15;
    LAS char* orow = lds0 + BST_OFF + qidx * 128;
    LAS float* mst = (LAS float*)(lds0 + BST_M); LAS float* lst = (LAS float*)(lds0 + BST_L);
    if (pat == 0) {
#pragma unroll
        for (int rr = 0; rr < 16; ++rr) { o[0][rr] = 0.f; o[1][rr] = 0.f; }
    } else {
#pragma unroll
        for (int db = 0; db < 2; ++db)
#pragma unroll
            for (int g = 0; g < 4; ++g) { const u32x2 w = *(const LAS u32x2*)(orow + (((8 * db + 2 * g + h) ^ swz) << 3));
                o[db][4 * g] = __uint_as_float(w.x << 16); o[db][4 * g + 1] = __uint_as_float(w.x & 0xffff0000u); o[db][4 * g + 2] = __uint_as_float(w.y << 16); o[db][4 * g + 3] = __uint_as_float(w.y & 0xffff0000u); }
        m = mst[qidx]; l = lst[h * 512 + qidx];
    }
    const int vw_off = (lane >> 3) * 128 + (((lane & 7) * 16) ^ (((lane >> 4) & 1) << 6));
    const int kw_off = 4096 + (lane >> 3) * 128 + (((lane & 7) ^ ((lane >> 4) & 7)) << 4);
    const int kr_base = 4096 + q * 128, kr_sw = (q >> 1) & 7;
    const int sw = (lane >> 3) & 1;
    const int trb = (4 * h + ((lane & 15) >> 2)) * 128 + 32 * ((lane >> 4) & 1) + 8 * (lane & 3);
    const LAS char* tr0 = vst + trb + 64 * sw;
    const LAS char* tr1 = vst + trb + 64 * (1 - sw);
    const int lim = 64 * dil;
    const int lo = (-lim > -qp) ? -lim : -qp, hi_ = (lim < SEQ - 1 - qp) ? lim : SEQ - 1 - qp;
    const unsigned span = (unsigned)(hi_ - lo);
#pragma unroll 1
    for (int kb = 0; kb < 5; ++kb) {
        const int ks = ks0 + 32 * dil * kb;
        bf16x8 kf[4];
#pragma unroll
        for (int i = 0; i < 4; ++i) { *(LAS bf16x8*)(vst + (kw_off ^ ((i & 1) << 6)) + i * 1024) = kn[i]; *(LAS bf16x8*)(vst + vw_off + i * 1024) = vn[i]; }
#pragma unroll
        for (int ds = 0; ds < 4; ++ds) kf[ds] = *(const LAS bf16x8*)(vst + kr_base + (((2 * ds + h) ^ kr_sw) << 4));
        if (kb + 1 < 5) {
            const int ks2 = ks + 32 * dil;
#pragma unroll
            for (int i = 0; i < 4; ++i) {
                int vp = ks2 + dil * (8 * i + (lane >> 3)); vp = vp < 0 ? 0 : (vp > SEQ - 1 ? SEQ - 1 : vp);
                kn[i] = *(const bf16x8*)(Kb + (size_t)vp * 512); vn[i] = *(const bf16x8*)(Vb + (size_t)vp * 512); }
        }
        f32x16 s;
#pragma unroll
        for (int rr = 0; rr < 16; ++rr) s[rr] = 0.f;
#pragma unroll
        for (int ds = 0; ds < 4; ++ds) s = __builtin_amdgcn_mfma_f32_32x32x16_bf16(kf[ds], qf[ds], s, 0, 0, 0);
        const int e1 = ks + dil * 4 * h - qp - lo;
#pragma unroll
        for (int rr = 0; rr < 16; ++rr) {
            const unsigned x = (unsigned)(e1 + dil * ((rr & 3) + 8 * (rr >> 2)));
            s[rr] = (x <= span) ? s[rr] : -1e30f;
        }
        bf16x8 pf[2];
        softmax_block(s, m, l, o, pat == 0 && kb == 0, pf);
#pragma unroll
        for (int s2 = 0; s2 < 2; ++s2)
#pragma unroll
            for (int db = 0; db < 2; ++db) {
                const LAS char* tp = (db == 0 ? tr0 : tr1) + s2 * 2048;
                const s16x4 lo4 = vtr(tp), hi4 = vtr(tp + 1024);
                const bf16x8 vf = (bf16x8){lo4[0], lo4[1], lo4[2], lo4[3], hi4[0], hi4[1], hi4[2], hi4[3]};
                o[db] = __builtin_amdgcn_mfma_f32_32x32x16_bf16(vf, pf[s2], o[db], 0, 0, 0);
            }
    }
    if (pat < 2) {
#pragma unroll
        for (int db = 0; db < 2; ++db)
#pragma unroll
            for (int g = 0; g < 4; ++g) { u32x2 w; w.x = cvtpk(o[db][4 * g], o[db][4 * g + 1]); w.y = cvtpk(o[db][4 * g + 2], o[db][4 * g + 3]);
                *(LAS u32x2*)(orow + (((8 * db + 2 * g + h) ^ swz) << 3)) = w; }
        if (h == 0) mst[qidx] = m;
        lst[h * 512 + qidx] = l;
    } else {
        const size_t row = (size_t)(b * SEQ + qp);
        attn_store(o, l, Y + row * 1024 + 512 + head * 64, ssb + row * 8 + head, h);
    }
}


__device__ __forceinline__ void attn_b_pair(const bf16_t* QB, const bf16_t* KB, const bf16_t* VB, bf16_t* Y, float* ssb, int b, int head, int c, int pat, int qoff0, LAS char* vst, LAS char* lds0, int lane) {
    const int q = lane & 31, h = lane >> 5;
    const int dil = (pat == 1) ? 4 : 1;
    int qidx[2], qp[2]; bf16x8 qf[2][4];
#pragma unroll
    for (int e = 0; e < 2; ++e) { qidx[e] = qoff0 + dil * (32 * e + q); qp[e] = 512 * c + qidx[e];
#pragma unroll
        for (int ds = 0; ds < 4; ++ds) qf[e][ds] = *(const bf16x8*)((const char*)(QB + (size_t)(b * SEQ) * 512 + head * 64) + ((unsigned)qp[e] * 1024u + (unsigned)h * 16u + ds * 32)); }
    const char* Kb = (const char*)(KB + (size_t)(b * SEQ) * 512 + head * 64);
    const char* Vb = (const char*)(VB + (size_t)(b * SEQ) * 512 + head * 64);
    const unsigned lo16 = (unsigned)(lane & 7) * 16u;
    const int ks0 = 512 * c + qoff0 - 64 * dil;
    bf16x8 kn[4], vn[4];
#pragma unroll
    for (int i = 0; i < 4; ++i) {
        int vp = ks0 + dil * (8 * i + (lane >> 3)); vp = vp < 0 ? 0 : (vp > SEQ - 1 ? SEQ - 1 : vp);
        const unsigned ko = (unsigned)vp * 1024u + lo16;
        kn[i] = *(const bf16x8*)(Kb + ko); vn[i] = *(const bf16x8*)(Vb + ko); }
    f32x16 o[2][2]; float m[2], l[2]; int lo[2]; unsigned span[2];
    LAS float* mst = (LAS float*)(lds0 + BST_M); LAS float* lst = (LAS float*)(lds0 + BST_L);
#pragma unroll
    for (int e = 0; e < 2; ++e) {
        const int swz = (qidx[e] ^ (qidx[e] >> 4)) & 15; const LAS char* orow = lds0 + BST_OFF + qidx[e] * 128;
#pragma unroll
        for (int db = 0; db < 2; ++db)
#pragma unroll
            for (int g = 0; g < 4; ++g) { const u32x2 w = *(const LAS u32x2*)(orow + (((8 * db + 2 * g + h) ^ swz) << 3));
                o[e][db][4 * g] = __uint_as_float(w.x << 16); o[e][db][4 * g + 1] = __uint_as_float(w.x & 0xffff0000u); o[e][db][4 * g + 2] = __uint_as_float(w.y << 16); o[e][db][4 * g + 3] = __uint_as_float(w.y & 0xffff0000u); }
        m[e] = mst[qidx[e]]; l[e] = lst[h * 512 + qidx[e]];
        const int lim = 64 * dil; lo[e] = (-lim > -qp[e]) ? -lim : -qp[e]; const int hi_ = (lim < SEQ - 1 - qp[e]) ? lim : SEQ - 1 - qp[e]; span[e] = (unsigned)(hi_ - lo[e]);
    }
    const int vw_off = (lane >> 3) * 128 + (((lane & 7) * 16) ^ (((lane >> 4) & 1) << 6));
    const int kw_off = 4096 + (lane >> 3) * 128 + (((lane & 7) ^ ((lane >> 4) & 7)) << 4);
    const int kr_base = 4096 + q * 128, kr_sw = (q >> 1) & 7;
    const int sw = (lane >> 3) & 1;
    const int trb = (4 * h + ((lane & 15) >> 2)) * 128 + 32 * ((lane >> 4) & 1) + 8 * (lane & 3);
    const LAS char* tr0 = vst + trb + 64 * sw;
    const LAS char* tr1 = vst + trb + 64 * (1 - sw);
#pragma unroll 1
    for (int t6 = 0; t6 < 6; ++t6) {
        const int ks = ks0 + 32 * dil * t6;
        bf16x8 kf[4];
#pragma unroll
        for (int i = 0; i < 4; ++i) { *(LAS bf16x8*)(vst + (kw_off ^ ((i & 1) << 6)) + i * 1024) = kn[i]; *(LAS bf16x8*)(vst + vw_off + i * 1024) = vn[i]; }
#pragma unroll
        for (int ds = 0; ds < 4; ++ds) kf[ds] = *(const LAS bf16x8*)(vst + kr_base + (((2 * ds + h) ^ kr_sw) << 4));
        if (t6 + 1 < 6) {
            const int ks2 = ks + 32 * dil;
#pragma unroll
            for (int i = 0; i < 4; ++i) {
                int vp = ks2 + dil * (8 * i + (lane >> 3)); vp = vp < 0 ? 0 : (vp > SEQ - 1 ? SEQ - 1 : vp);
                const unsigned ko = (unsigned)vp * 1024u + lo16;
                kn[i] = *(const bf16x8*)(Kb + ko); vn[i] = *(const bf16x8*)(Vb + ko); }
        }
        bf16x8 vf[2][2];
#pragma unroll
        for (int s2 = 0; s2 < 2; ++s2)
#pragma unroll
            for (int db = 0; db < 2; ++db) {
                const LAS char* tp = (db == 0 ? tr0 : tr1) + s2 * 2048;
                const s16x4 lo4 = vtr(tp), hi4 = vtr(tp + 1024);
                vf[s2][db] = (bf16x8){lo4[0], lo4[1], lo4[2], lo4[3], hi4[0], hi4[1], hi4[2], hi4[3]};
            }
#pragma unroll
        for (int e = 0; e < 2; ++e) {
            if ((e == 0 && t6 == 5) || (e == 1 && t6 == 0)) continue;
            f32x16 s;
#pragma unroll
            for (int rr = 0; rr < 16; ++rr) s[rr] = 0.f;
#pragma unroll
            for (int ds = 0; ds < 4; ++ds) s = __builtin_amdgcn_mfma_f32_32x32x16_bf16(kf[ds], qf[e][ds], s, 0, 0, 0);
            const int e1 = ks + dil * 4 * h - qp[e] - lo[e];
#pragma unroll
            for (int rr = 0; rr < 16; ++rr) {
                const unsigned x = (unsigned)(e1 + dil * ((rr & 3) + 8 * (rr >> 2)));
                s[rr] = (x <= span[e]) ? s[rr] : -1e30f;
            }
            bf16x8 pf[2];
            softmax_block(s, m[e], l[e], o[e], false, pf);
#pragma unroll
            for (int s2 = 0; s2 < 2; ++s2)
#pragma unroll
                for (int db = 0; db < 2; ++db) o[e][db] = __builtin_amdgcn_mfma_f32_32x32x16_bf16(vf[s2][db], pf[s2], o[e][db], 0, 0, 0);
        }
    }
#pragma unroll
    for (int e = 0; e < 2; ++e) {
        if (pat < 2) {
            const int swz = (qidx[e] ^ (qidx[e] >> 4)) & 15; LAS char* orow = lds0 + BST_OFF + qidx[e] * 128;
#pragma unroll
            for (int db = 0; db < 2; ++db)
#pragma unroll
                for (int g = 0; g < 4; ++g) { u32x2 w; w.x = cvtpk(o[e][db][4 * g], o[e][db][4 * g + 1]); w.y = cvtpk(o[e][db][4 * g + 2], o[e][db][4 * g + 3]);
                    *(LAS u32x2*)(orow + (((8 * db + 2 * g + h) ^ swz) << 3)) = w; }
            if (h == 0) mst[qidx[e]] = m[e];
            lst[h * 512 + qidx[e]] = l[e];
        } else {
            const size_t row = (size_t)(b * SEQ + qp[e]);
            attn_store(o[e], l[e], Y + row * 1024 + 512 + head * 64, ssb + row * 8 + head, h);
        }
    }
}

constexpr int I_IN = 16 * 72, I_OUT = 16 * 32, I_1 = 16 * 128, I_2 = 64 * 32, I_L = I_IN + I_OUT + I_1 + I_2;
__device__ __forceinline__ void convert_layer(const Params& p, int L, int it0, int nstep, LAS float* scr, int lane, int ibeg, int iend) {
    bf16_t* wl = (bf16_t*)(p.ws + WS_W + (size_t)L * W_LAYER);
    for (int it = ibeg + it0; it < iend; it += nstep) {
        int r = it;
        if (r < I_IN) { const int kb = r / 72, nb = r % 72, n0 = 32 * nb, k0 = 64 * kb;
            const int ot = n0 >> 8, pos = (ot == 7) ? 0 : ((ot == 8) ? 4 : ((ot <= 2) ? ot + 1 : ot + 2));
            const int d0 = pos * 256 + ((n0 >> 5) & 1) * 128 + ((n0 >> 6) & 3) * 32;
            transpose_item(p.w_in + (size_t)L * DM * INW, DM, INW, wl, k0, n0, d0, p.norm1 + L * DM + k0, scr, lane); continue; }
        r -= I_IN;
        if (r < I_OUT) { const int kb = r / 32, nb = r % 32, n0 = 32 * nb, k0 = 64 * kb;
            const float* g0 = (k0 < 512) ? p.out_norm_a + L * 512 + k0 : p.out_norm_b + L * 512 + (k0 - 512);
            transpose_item(p.w_out + (size_t)L * DM * DM, DM, DM, wl + 2359296, k0, n0, n0, g0, scr, lane); continue; }
        r -= I_OUT;
        if (r < I_1) { const int kb = r / 128, nb = r % 128, n0 = 32 * nb, k0 = 64 * kb;
            transpose_item(p.w_mlp_in + (size_t)L * DM * FF, DM, FF, wl + 2359296 + 1048576, k0, n0, n0, p.norm2 + L * DM + k0, scr, lane); continue; }
        r -= I_1;
        { const int kb = r / 32, nb = r % 32, n0 = 32 * nb, k0 = 64 * kb;
            transpose_item(p.w_mlp_out + (size_t)L * FF * DM, FF, DM, wl + 2359296 + 1048576 + 4194304, k0, n0, n0, nullptr, scr, lane); }
    }
}

#define XB_TMO      128
#define XB_XCNT(j)  (256  + 64 * (j))
#define XB_XSUB(j)  (1280 + 64 * (j))
#define XB_XGEN(j)  (2304 + 64 * (j))
#define XB_TOP      3328
#define XB_TOPGEN   3392
#define XCD_BAR_WORDS 3456
#define XB_SPIN_CAP (1u << 18)

__device__ __forceinline__ unsigned xb_ld(unsigned* p)              { return __hip_atomic_load(p, __ATOMIC_RELAXED, __HIP_MEMORY_SCOPE_AGENT); }
__device__ __forceinline__ unsigned xb_add(unsigned* p, unsigned v) { return __hip_atomic_fetch_add(p, v, __ATOMIC_RELAXED, __HIP_MEMORY_SCOPE_AGENT); }
__device__ __forceinline__ unsigned xb_xcc_id() { return (unsigned)__builtin_amdgcn_s_getreg((3 << 11) | 20) & 0xFu; }
#define XB_SPIN(cond, bar) do { unsigned _sp = 0; while (cond) { __builtin_amdgcn_s_sleep(1); \
    if ((++_sp & 255u) == 0u) { if (xb_ld(&(bar)[XB_TMO])) break; if (_sp > XB_SPIN_CAP) { atomicAdd(&(bar)[XB_TMO], 1u); break; } } } } while (0)

struct XcdBarrier {
    unsigned* bar; unsigned x;
    volatile LAS unsigned* st;
};

__device__ __forceinline__ XcdBarrier xcd_barrier_post(unsigned* bar, volatile LAS unsigned* st) {
    XcdBarrier b; b.bar = bar; b.x = xb_xcc_id(); b.st = st;
    if (threadIdx.x == 0) (void)xb_add(&bar[XB_XCNT(b.x)], 1u);
    return b;
}
__device__ __forceinline__ void xcd_barrier_complete(unsigned* bar, unsigned x, unsigned& nloc, unsigned& nx) {
    const unsigned G = gridDim.x * gridDim.y * gridDim.z;
    unsigned sum, cnt, mine, sp = 0u;
    for (;;) {
        sum = 0u; cnt = 0u; mine = 0u;
        unsigned cv[16];
#pragma unroll
        for (unsigned j = 0; j < 16; ++j) cv[j] = xb_ld(&bar[XB_XCNT(j)]);
#pragma unroll
        for (unsigned j = 0; j < 16; ++j) { const unsigned c = cv[j]; sum += c; cnt += (c > 0u) ? 1u : 0u; mine = (j == x) ? c : mine; }
        if (sum == G) break;
        __builtin_amdgcn_s_sleep(1);
        if ((++sp & 255u) == 0u) { if (xb_ld(&bar[XB_TMO])) break; if (sp > XB_SPIN_CAP) { atomicAdd(&bar[XB_TMO], 1u); break; } }
    }
    nloc = mine > 0u ? mine : 1u; nx = cnt > 0u ? cnt : 1u;
}

__device__ __forceinline__ void xcd_barrier(const XcdBarrier& b) {
    asm volatile("s_waitcnt vmcnt(0)" ::: "memory");
    __syncthreads();
    if (threadIdx.x == 0) {
        unsigned* bar = b.bar; unsigned bxcc = b.x; asm volatile("" : "+s"(bxcc));
        __builtin_amdgcn_s_waitcnt(0);
        unsigned nloc = b.st[0], nx = b.st[1];
        if (nloc == 0u) { xcd_barrier_complete(bar, bxcc, nloc, nx); b.st[0] = nloc; b.st[1] = nx; }
        const unsigned old = xb_add(&bar[XB_XSUB(bxcc)], 1u);
        const unsigned gen = old / nloc;
        if (old + 1u == (gen + 1u) * nloc) {
            __builtin_amdgcn_fence(__ATOMIC_RELEASE, "agent");
            asm volatile("s_waitcnt vmcnt(0)" ::: "memory");
            const unsigned og = xb_add(&bar[XB_TOP], 1u);
            const unsigned tg = og / nx;
            if (og + 1u == (tg + 1u) * nx) xb_add(&bar[XB_TOPGEN], 1u);
            else XB_SPIN(xb_ld(&bar[XB_TOPGEN]) == tg, bar);
            __builtin_amdgcn_fence(__ATOMIC_ACQUIRE, "agent");
            xb_add(&bar[XB_XGEN(bxcc)], 1u);
            asm volatile("s_waitcnt vmcnt(0)" ::: "memory");
        } else {
            XB_SPIN(xb_ld(&bar[XB_XGEN(bxcc)]) == gen, bar);
            __builtin_amdgcn_fence(__ATOMIC_ACQUIRE, "agent");
            asm volatile("s_waitcnt vmcnt(0)" ::: "memory");
        }
    }
    __syncthreads();
}

#define CG_SYNC() do { asm volatile("s_waitcnt vmcnt(0) lgkmcnt(0)" ::: "memory"); grid.sync(); __builtin_amdgcn_fence(__ATOMIC_ACQUIRE, "agent"); asm volatile("s_waitcnt vmcnt(0)" ::: "memory"); } while (0)
#define GRID_SYNC() xcd_barrier(xbar)
constexpr int ATT_NQ = 2;
#ifdef TS_SEL
#define TS_INIT() float* TS = (float*)(p.ws + 600000); unsigned long long tprev = 0; if (blockIdx.x == 0 && threadIdx.x == 0) { for (int i = 0; i < 16; ++i) TS[i] = 0.f; tprev = __builtin_amdgcn_s_memrealtime(); }
#define STAMP(slot) do { if (blockIdx.x == 0 && threadIdx.x == 0) { asm volatile("s_waitcnt vmcnt(0) lgkmcnt(0)" ::: "memory"); const unsigned long long now_ = __builtin_amdgcn_s_memrealtime(); TS[slot] += (float)(now_ - tprev); tprev = now_; } } while (0)
#define TS_FINISH() do { if (blockIdx.x == 0 && threadIdx.x == 0) p.out[0] = TS[TS_SEL] * 0.01f; } while (0)
#else
#define TS_INIT() do {} while (0)
#define STAMP(slot) do {} while (0)
#define TS_FINISH() do {} while (0)
#endif
__global__ void __launch_bounds__(512) fwd_megakernel(Params p) {
    extern __shared__ __attribute__((aligned(16))) unsigned char lds_raw[];
    LAS unsigned char* lds = (LAS unsigned char*)lds_raw;
    cg::grid_group grid = cg::this_grid();
    const int tid = threadIdx.x, lane = tid & 63, wave = __builtin_amdgcn_readfirstlane(tid >> 6);
    const int G = gridDim.x, bx = blockIdx.x;
    const int gw = bx * 8 + wave, NGW = G * 8;
    unsigned char* ws = p.ws;
    float* cosA = (float*)(ws + WS_COSA); float* sinA = (float*)(ws + WS_SINA); float* cosB = (float*)(ws + WS_COSB); float* sinB = (float*)(ws + WS_SINB);
    float* SSP = (float*)(ws + WS_SS); float* SSA = SSP + (size_t)M * 16; float* SSB = SSA + (size_t)M * 8;
    bf16_t* XB = (bf16_t*)(ws + WS_XB);
    bf16_t* HB = (bf16_t*)(ws + WS_H);
    bf16_t *QA = (bf16_t*)(ws + WS_QA), *KA = (bf16_t*)(ws + WS_KA), *VA = (bf16_t*)(ws + WS_VA), *QB = (bf16_t*)(ws + WS_QB), *KB = (bf16_t*)(ws + WS_KB), *VB = (bf16_t*)(ws + WS_VB), *Y = (bf16_t*)(ws + WS_Y);

    TS_INIT();
    volatile LAS unsigned* xst = (volatile LAS unsigned*)(lds + 139264 - 64);
    if (tid < 2) xst[tid] = 0u;
    {
        unsigned* barw = (unsigned*)(ws + WS_BAR);
        const unsigned stale = (unsigned)__builtin_amdgcn_readfirstlane((int)xb_ld(barw + 4000));
        if (stale != 0u) {
            if (bx == 0) for (int i = tid; i < (int)(BAR_BYTES / 4); i += 512) if (i != 4000) __hip_atomic_store(barw + i, 0u, __ATOMIC_RELAXED, __HIP_MEMORY_SCOPE_AGENT);
            CG_SYNC();
        }
    }
    XcdBarrier xbar = xcd_barrier_post((unsigned*)(ws + WS_BAR), xst);
    {
        LAS float* scr = (LAS float*)(lds + wave * 16384);
        { const int n3 = 576 - 2 * G; const bool hide = (n3 > 0 && n3 < G);
          if (hide) convert_layer(p, 0, gw, NGW, scr, lane, 0, I_IN);
          else for (int L0 = 0; L0 < DEPTH; ++L0) convert_layer(p, L0, gw, NGW, scr, lane, 0, I_L); }
        for (int mrow = gw; mrow < M; mrow += NGW) {
            const f32x4* xr = (const f32x4*)(p.x + (size_t)mrow * DM) + lane; float s = 0.f;
            unsigned long long* o8 = (unsigned long long*)(XB + (size_t)mrow * DM) + lane;
#pragma unroll
            for (int j = 0; j < 4; ++j) { const f32x4 v = __builtin_nontemporal_load(xr + 64 * j); s += (v[0] * v[0] + v[1] * v[1]) + (v[2] * v[2] + v[3] * v[3]);
                o8[64 * j] = (unsigned long long)pk2(v[0], v[1]) | ((unsigned long long)pk2(v[2], v[3]) << 32); }
            s = wave_sum(s);
            if (lane < 16) SSP[(size_t)mrow * 16 + lane] = (lane == 0) ? s : 0.f;
        }
        for (int i = bx * 512 + tid; i < 64 * 16 + 4096 * 8; i += G * 512) {
            int fi, pos; if (i < 1024) { fi = i & 15; pos = i >> 4; } else { fi = 16 + ((i - 1024) & 7); pos = (i - 1024) >> 3; }
            double f = 0.0;
#pragma unroll
            for (int k = 0; k < 24; ++k) if (fi == k) f = p.frev[k];
            double rev = (double)pos * f; rev -= floor(rev);
            const float fr = (float)rev;
            const float sv = __builtin_amdgcn_sinf(fr), cv = __builtin_amdgcn_cosf(fr);
            if (i < 1024) { cosA[i] = cv; sinA[i] = sv; } else { cosB[i - 1024] = cv; sinB[i - 1024] = sv; }
        }
    }
    STAMP(0); GRID_SYNC(); STAMP(7);

    for (int L = 0; L < DEPTH; ++L) {
        const bf16_t* wl = (const bf16_t*)(ws + WS_W + (size_t)L * W_LAYER);
        const bf16_t* Win = wl; const bf16_t* Wout = wl + 2359296; const bf16_t* W1 = Wout + 1048576; const bf16_t* W2 = W1 + 4194304;
        float* ss1 = SSP; float* ss2 = SSP; float* ssn = SSP; float* ssa = SSA; float* ssb = SSB;
        {
            pg8::Gemm g{XB, Win, M, INW, DM}; pg8::StaticOrder S; S.init(M, INW, G, bx);
            pg8::EpiInProj E{ss1, p.q_norm + L * 64, p.k_norm + L * 64, cosA, sinA, cosB, sinB, QA, KA, VA, QB, KB, VB};
            pg8::gemm_phase<pg8::EpiInProj, pg8::StaticOrder, true, true>(lds, g, S, E);
            const int n3 = 576 - 2 * G;
            if (L == 0 && n3 > 0 && n3 < G && bx >= n3) { int lane_d = lane; asm volatile("" : "+v"(lane_d));
                convert_layer(p, 0, (bx - n3) * 8 + wave, (G - n3) * 8, (LAS float*)(lds + wave * 16384), lane_d, I_IN, I_L); }
            if (L + 1 < DEPTH && n3 > 0 && n3 < G && bx >= n3) { int lane_c = lane; asm volatile("" : "+v"(lane_c));
                convert_layer(p, L + 1, (bx - n3) * 8 + wave, (G - n3) * 8, (LAS float*)(lds + wave * 16384), lane_c, 0, I_L); }
        }
        STAMP(1); GRID_SYNC(); STAMP(7);
        {
            int lane_ = lane; asm volatile("" : "+v"(lane_));
            const int lane = lane_;
            LAS char* vst = (LAS char*)(lds + wave * 8192);
            const int vb = (bx & 7) * (G >> 3) + (bx >> 3);
            for (int u0 = vb; u0 < 256; u0 += G)
#pragma unroll 1
                for (int i = 0; i < 2; ++i) { const int u = 2 * u0 + i;
                    attn_body::attn_unit<8>(u >> 7, (u & 63) >> 3, 8 * ((u >> 6) & 1) + (u & 7), (const attn_body::bf16*)QA, (const attn_body::bf16*)KA, (const attn_body::bf16*)VA, (attn_body::bf16*)Y, ssa, (char*)lds_raw); }
            STAMP(2);
            for (int grp = vb; grp < BATCH * 8 * 8; grp += G) {
                const int b = grp >> 6, head = (grp & 31) >> 2, c = 4 * ((grp >> 5) & 1) + (grp & 3);
                int lane_b = lane; asm volatile("" : "+v"(lane_b));
                const int lane = lane_b;
#pragma unroll 1
                for (int jj = 0; jj < 2; ++jj) attn_b_task(QB, KB, VB, Y, ssb, b, head, c, 0, wave + 8 * jj, vst, (LAS char*)lds, lane);
                asm volatile("s_waitcnt lgkmcnt(0)" ::: "memory"); __syncthreads();
#pragma unroll 1
                for (int pat = 1; pat < 3; ++pat) {
                    const int qoff0 = (pat == 1) ? ((wave & 3) + 256 * (wave >> 2)) : 64 * wave;
                    attn_b_pair(QB, KB, VB, Y, ssb, b, head, c, pat, qoff0, vst, (LAS char*)lds, lane);
                    asm volatile("s_waitcnt lgkmcnt(0)" ::: "memory"); __syncthreads();
                }
            }
        }
        STAMP(3); GRID_SYNC(); STAMP(7);
        {
            pg8::Gemm g{Y, Wout, M, DM, DM}; pg8::StaticOrder S; S.init(M, DM, G, bx);
            pg8::EpiRes<true> E{XB, ss2, ssa, ssb};
            pg8::gemm_phase<pg8::EpiRes<true>, pg8::StaticOrder, true, true>(lds, g, S, E);
        }
        STAMP(4); GRID_SYNC(); STAMP(7);
        {
            pg8::Gemm g{XB, W1, M, FF, DM}; pg8::StaticOrder S; S.init(M, FF, G, bx);
            pg8::EpiMlpIn E{ss2, HB};
            pg8::gemm_phase<pg8::EpiMlpIn, pg8::StaticOrder, true, true>(lds, g, S, E);
        }
        STAMP(5); GRID_SYNC(); STAMP(7);
        {
            pg8::Gemm g{HB, W2, M, DM, FF}; pg8::StaticOrder S; S.init(M, DM, G, bx);
            pg8::EpiRes<false> E{XB, ssn, nullptr, nullptr};
            pg8::gemm_phase<pg8::EpiRes<false>, pg8::StaticOrder, true, true>(lds, g, S, E);
        }
        STAMP(6); GRID_SYNC(); STAMP(7);
    }
    {
        int lane_f = lane; asm volatile("" : "+v"(lane_f));
        const int lane = lane_f;
        int tid_f = threadIdx.x; asm volatile("" : "+v"(tid_f));
        const int gw_f = (int)blockIdx.x * 8 + __builtin_amdgcn_readfirstlane(tid_f >> 6);
        const float* ssf = SSP;
        for (int mrow = gw_f; mrow < M; mrow += NGW) {
            const float rs = rsqrtf(pg8::sum16(ssf + (size_t)mrow * 16) * (1.0f / 1024.0f) + 1e-6f);
            f32x4* xr = (f32x4*)(p.out + (size_t)mrow * DM) + lane; const f32x4* gr = (const f32x4*)p.final_norm + lane;
            const u32x2* xbr = (const u32x2*)(XB + (size_t)mrow * DM) + lane;
#pragma unroll
            for (int j = 0; j < 4; ++j) { const u32x2 w = __builtin_nontemporal_load(xbr + 64 * j);
                const f32x4 v = (f32x4){__uint_as_float(w.x << 16), __uint_as_float(w.x & 0xffff0000u), __uint_as_float(w.y << 16), __uint_as_float(w.y & 0xffff0000u)};
                __builtin_nontemporal_store(v * rs * gr[64 * j], xr + 64 * j); }
        }
    }
    STAMP(8); TS_FINISH();
}

extern "C" void kernel_launch(void* const* d_in, const int* in_sizes, int n_in, void* d_out, int out_size, void* d_ws, size_t ws_size, hipStream_t stream) {
    static int grid_blocks = 0;
    if (grid_blocks == 0) {
        if (n_in != 12 || ws_size < WS_END) { fprintf(stderr, "kernel_launch: unexpected inputs (n_in %d, ws %zu)\n", n_in, ws_size); grid_blocks = -1; return; }
        int dev = 0, cus = 0, per_cu = 0;
        hipGetDevice(&dev);
        hipDeviceGetAttribute(&cus, hipDeviceAttributeMultiprocessorCount, dev);
        hipFuncSetAttribute((const void*)fwd_megakernel, hipFuncAttributeMaxDynamicSharedMemorySize, LDS_BYTES);
        hipOccupancyMaxActiveBlocksPerMultiprocessor(&per_cu, (const void*)fwd_megakernel, 512, LDS_BYTES);
        if (per_cu < 1) { fprintf(stderr, "kernel_launch: occupancy query says %d blocks per CU\n", per_cu); grid_blocks = -1; return; }
        grid_blocks = cus * per_cu;
        if (grid_blocks % 8 != 0) grid_blocks -= grid_blocks % 8;
    }
    if (grid_blocks < 0) return;
    Params p{};
    p.x = (const float*)d_in[0]; p.norm1 = (const float*)d_in[1]; p.w_in = (const float*)d_in[2]; p.q_norm = (const float*)d_in[3]; p.k_norm = (const float*)d_in[4];
    p.out_norm_a = (const float*)d_in[5]; p.out_norm_b = (const float*)d_in[6]; p.w_out = (const float*)d_in[7]; p.norm2 = (const float*)d_in[8];
    p.w_mlp_in = (const float*)d_in[9]; p.w_mlp_out = (const float*)d_in[10]; p.final_norm = (const float*)d_in[11];
    p.out = (float*)d_out; p.ws = (unsigned char*)d_ws;
    const double two_pi = 6.283185307179586476925286766559;
    for (int i = 0; i < 16; ++i) p.frev[i] = pow(10000.0, -(double)i / 16.0) / two_pi;
    for (int i = 0; i < 8; ++i) p.frev[16 + i] = pow(500000.0, -(double)i / 8.0) / two_pi;
    if (hipMemsetAsync((char*)d_ws + WS_BAR, 0, BAR_BYTES, stream) != hipSuccess) { fprintf(stderr, "kernel_launch: memset of the barrier words failed\n"); return; }
    void* args[] = {&p};
    hipError_t e = hipLaunchCooperativeKernel((const void*)fwd_megakernel, dim3(grid_blocks), dim3(512), args, LDS_BYTES, stream);
    if (e != hipSuccess) fprintf(stderr, "cooperative launch failed: %s (grid %d)\n", hipGetErrorString(e), grid_blocks);
}
```
